# Optimizing an MI355X kernel written in HIP

```python
import jax
import jax.numpy as jnp
from jax import lax
import numpy as np


D_MODEL = 1024
BATCH = 4
SEQ = 4096
DEPTH = 4
DEC_BATCH = 4
DEC_SEQ = 8192
PAST_LEN = 128

GRID_W = 64
PLE_DIM = 256
EPS = 1e-6
POOL_WIDTH = 512
POOL_GROUPS = 4
POOL_GDIM = POOL_WIDTH // POOL_GROUPS
POOL_WINDOWS = (2, 4, 8, 16)
HG_HEADS = 4
HG_DK = 128
HG_DV = 128
HG_KW = HG_HEADS * HG_DK
HG_VW = HG_HEADS * HG_DV
HG_CHUNK = 64
ATT_HEADS = 16
ATT_KV_HEADS = 4
HEAD_DIM = 64
ATT_GROUP = ATT_HEADS // ATT_KV_HEADS
ATT_QW = ATT_HEADS * HEAD_DIM
ATT_KVW = ATT_KV_HEADS * HEAD_DIM
Q_BLOCK = 128
ROPE_THETA = 10000.0
ROPE_HALF = HEAD_DIM // 2
N_BRANCH = 3
D_FF = 2816
CONV_W = 3

OFF_POOL = 0
OFF_HQ = OFF_POOL + POOL_WIDTH
OFF_HFF = OFF_HQ + HG_KW
OFF_HFB = OFF_HFF + HG_KW
OFF_HI = OFF_HFB + HG_KW
OFF_HG = OFF_HI + HG_VW
OFF_AQ = OFF_HG + HG_VW
OFF_AK = OFF_AQ + ATT_QW
OFF_AV = OFF_AK + ATT_KVW
OFF_GATE = OFF_AV + ATT_KVW
IN_WIDTH = OFF_GATE + N_BRANCH * D_MODEL

kernel_name = 'hybrid_pool_hgrn2_gqa_encoder'


def _rmsnorm(x, g):
    xf = x.astype(jnp.float32)
    y = xf * lax.rsqrt(jnp.mean(xf * xf, axis=-1, keepdims=True) + EPS)
    return (y * g.astype(jnp.float32)).astype(x.dtype)


def _pool_mixer(u, w_grp, scale):
    b, n, _ = u.shape
    ug = u.reshape(b, n, POOL_GROUPS, POOL_GDIM).astype(jnp.float32)
    cs = jnp.concatenate([jnp.zeros((b, 1, POOL_GROUPS, POOL_GDIM), jnp.float32), jnp.cumsum(ug, axis=1)], axis=1)
    t = jnp.arange(n)[:, None]
    half = jnp.array([w // 2 for w in POOL_WINDOWS], jnp.int32)[None, :]
    lo = jnp.clip(t - half, 0, n)
    hi = jnp.clip(t + half, 0, n)
    gi = jnp.arange(POOL_GROUPS)[None, :]
    win_sum = cs[:, hi, gi, :] - cs[:, lo, gi, :]
    cnt = (hi - lo).astype(jnp.float32)[None, :, :, None]
    mixed = (win_sum / cnt - ug).astype(u.dtype)
    y = jnp.einsum('bngc,gcd->bngd', mixed, w_grp) * scale.reshape(POOL_GROUPS, POOL_GDIM)
    return y.reshape(b, n, POOL_WIDTH)


def _lower_bound(lb_raw):
    s = jnp.cumsum(jax.nn.softmax(lb_raw.astype(jnp.float32), axis=0), axis=0)
    return s - s[0:1]


def _gla_chunk_scan(q, k, v, logf):
    b, n, h, dk = q.shape
    dv = v.shape[-1]
    nc = n // HG_CHUNK

    def chunks(a):
        return a.reshape(b, nc, HG_CHUNK, h, a.shape[-1]).transpose(1, 0, 3, 2, 4)

    causal = jnp.tril(jnp.ones((HG_CHUNK, HG_CHUNK), bool))[:, :, None]

    def step(state, xs):
        qc, kc, vc, gc = xs
        cum = jnp.cumsum(gc, axis=2)
        rel = jnp.where(causal, cum[:, :, :, None, :] - cum[:, :, None, :, :], -jnp.inf)
        scores = jnp.einsum('bhjc,bhjlc,bhlc->bhjl', qc, jnp.exp(rel), kc)
        out = jnp.einsum('bhjl,bhlv->bhjv', scores, vc) + jnp.einsum('bhjc,bhcv->bhjv', qc * jnp.exp(cum), state)
        last = cum[:, :, -1:, :]
        state = jnp.exp(last[:, :, 0, :])[..., None] * state + jnp.einsum('bhlc,bhlv->bhcv', kc * jnp.exp(last - cum), vc)
        return state, out

    s0 = jnp.zeros((b, h, dk, dv), jnp.float32)
    _, out = lax.scan(step, s0, (chunks(q), chunks(k), chunks(v), chunks(logf)))
    return out.transpose(1, 0, 3, 2, 4).reshape(b, n, h, dv)


def _hgrn2_mixer(zq, zff, zfb, zi, zg, lb_f, lb_b, g_onorm):
    b, n, _ = zq.shape

    def heads(a, d):
        return a.astype(jnp.float32).reshape(b, n, HG_HEADS, d)

    q = heads(zq, HG_DK) * HG_DK ** -0.5
    v = heads(zi, HG_DV)

    def gates(z, lb):
        lbh = lb.reshape(HG_HEADS, HG_DK)
        logf = jnp.logaddexp(jnp.log(lbh), jnp.log1p(-lbh) + jax.nn.log_sigmoid(z))
        k = (1.0 - lbh) * jax.nn.sigmoid(-z)
        return k, logf

    k_fw, logf_fw = gates(heads(zff, HG_DK), lb_f)
    k_bw, logf_bw = gates(heads(zfb, HG_DK), lb_b)
    o_fw = _gla_chunk_scan(q, k_fw, v, logf_fw)

    def flip(a):
        return jnp.flip(a, axis=1)

    o_bw = flip(_gla_chunk_scan(flip(q), flip(k_bw), flip(v), flip(logf_bw)))
    o = _rmsnorm(o_fw + o_bw, g_onorm).reshape(b, n, HG_VW) * jax.nn.silu(zg.astype(jnp.float32))
    return o.astype(zq.dtype)


def _axial_rope_tables(n):
    rows = n // GRID_W
    row = jnp.repeat(jnp.arange(rows, dtype=jnp.float32), GRID_W)
    col = jnp.tile(jnp.arange(GRID_W, dtype=jnp.float32), rows)
    inv_freq = 1.0 / (ROPE_THETA ** (jnp.arange(0, ROPE_HALF, 2, dtype=jnp.float32) / ROPE_HALF))
    ang = jnp.concatenate([row[:, None] * inv_freq, col[:, None] * inv_freq], axis=-1)
    return jnp.cos(ang), jnp.sin(ang)


def _apply_axial_rope(x, cos, sin):
    b, n, h, d = x.shape
    xs = x.reshape(b, n, h, 2, 2, ROPE_HALF // 2)
    c = cos.reshape(n, 1, 2, ROPE_HALF // 2)
    s = sin.reshape(n, 1, 2, ROPE_HALF // 2)
    x1 = xs[..., 0, :]
    x2 = xs[..., 1, :]
    y1 = x1 * c - x2 * s
    y2 = x2 * c + x1 * s
    return jnp.stack([y1, y2], axis=-2).reshape(b, n, h, d)


def _gqa_axial(zq, zk, zv, g_q, g_k, cos, sin):
    b, n, _ = zq.shape
    dt = zq.dtype
    q = _rmsnorm(zq.reshape(b, n, ATT_HEADS, HEAD_DIM), g_q).astype(jnp.float32)
    k = _rmsnorm(zk.reshape(b, n, ATT_KV_HEADS, HEAD_DIM), g_k).astype(jnp.float32)
    q = (_apply_axial_rope(q, cos, sin) * HEAD_DIM ** -0.5).astype(dt)
    k = _apply_axial_rope(k, cos, sin).astype(dt)
    v = zv.reshape(b, n, ATT_KV_HEADS, HEAD_DIM)
    nb = n // Q_BLOCK
    qb = q.reshape(b, nb, Q_BLOCK, ATT_KV_HEADS, ATT_GROUP, HEAD_DIM).transpose(1, 0, 3, 4, 2, 5)
    kt = k.transpose(0, 2, 1, 3)
    vt = v.transpose(0, 2, 1, 3)

    def block(qblk):
        s = jnp.einsum('bkgqd,bknd->bkgqn', qblk, kt, preferred_element_type=jnp.float32)
        p = jax.nn.softmax(s, axis=-1)
        return jnp.einsum('bkgqn,bknd->bkgqd', p.astype(dt), vt)

    o = lax.map(block, qb)
    return o.transpose(1, 0, 4, 2, 3, 5).reshape(b, n, ATT_QW)


def _conv_glu_ffn(h, w_up, conv_w, conv_b, w_down):
    u = h @ w_up
    up = jnp.pad(u, ((0, 0), (1, 1), (0, 0)))
    c = up[:, :-2] * conv_w[0] + up[:, 1:-1] * conv_w[1] + up[:, 2:] * conv_w[2] + conv_b
    a, g = jnp.split(c, 2, axis=-1)
    return (jax.nn.gelu(a, approximate=True) * g) @ w_down


def _trunk(x, p, cos, sin, g_mix, w_in, pool_w, pool_scale, lb_f, lb_b, hg_onorm, g_q, g_k,
           w_br_pool, w_br_hg, w_br_att, w_out, g_ffn, w_up, conv_w, conv_b, w_down,
           g_ple, w_ple_gate, w_ple, g_final):
    for i in range(DEPTH):
        h = _rmsnorm(x, g_mix[i])
        z = h @ w_in[i]
        y_pool = _pool_mixer(z[..., OFF_POOL:OFF_HQ], pool_w[i], pool_scale[i])
        y_hg = _hgrn2_mixer(z[..., OFF_HQ:OFF_HFF], z[..., OFF_HFF:OFF_HFB], z[..., OFF_HFB:OFF_HI],
                            z[..., OFF_HI:OFF_HG], z[..., OFF_HG:OFF_AQ], lb_f[i], lb_b[i], hg_onorm[i])
        y_att = _gqa_axial(z[..., OFF_AQ:OFF_AK], z[..., OFF_AK:OFF_AV], z[..., OFF_AV:OFF_GATE],
                           g_q[i], g_k[i], cos, sin)
        gates = jax.nn.sigmoid(z[..., OFF_GATE:].astype(jnp.float32)).astype(x.dtype)
        gates = gates.reshape(z.shape[0], z.shape[1], N_BRANCH, D_MODEL)
        merged = (gates[..., 0, :] * (y_pool @ w_br_pool[i])
                  + gates[..., 1, :] * (y_hg @ w_br_hg[i])
                  + gates[..., 2, :] * (y_att @ w_br_att[i]))
        x = x + merged @ w_out[i]
        x = x + _conv_glu_ffn(_rmsnorm(x, g_ffn[i]), w_up[i], conv_w[i], conv_b[i], w_down[i])
        ple_gate = jax.nn.sigmoid(_rmsnorm(x, g_ple[i]) @ w_ple_gate[i])
        x = x + ple_gate * (p[i] @ w_ple[i])
    return _rmsnorm(x, g_final)


def setup_inputs(seed: int = 0) -> dict:
    key = jax.random.key(seed)
    ks = iter(jax.random.split(key, 32))

    def nrm(shape, scale):
        return jax.random.normal(next(ks), shape, jnp.float32) * scale

    def gain(shape):
        return 1.0 + nrm(shape, 0.02)

    return {
        'x_prompt': nrm((BATCH, SEQ, D_MODEL), 1.0),
        'x_sample': nrm((DEC_BATCH, DEC_SEQ, D_MODEL), 1.0),
        'p_prompt': nrm((DEPTH, BATCH, SEQ, PLE_DIM), 1.0),
        'p_sample': nrm((DEPTH, DEC_BATCH, DEC_SEQ, PLE_DIM), 1.0),
        'g_mix': gain((DEPTH, D_MODEL)),
        'w_in': nrm((DEPTH, D_MODEL, IN_WIDTH), D_MODEL ** -0.5),
        'pool_w': nrm((DEPTH, POOL_GROUPS, POOL_GDIM, POOL_GDIM), POOL_GDIM ** -0.5),
        'pool_scale': 1.0 + nrm((DEPTH, POOL_WIDTH), 0.1),
        'lb_raw_f': nrm((DEPTH, HG_KW), 0.1),
        'lb_raw_b': nrm((DEPTH, HG_KW), 0.1),
        'hg_onorm': gain((DEPTH, HG_DV)),
        'g_q': gain((DEPTH, HEAD_DIM)),
        'g_k': gain((DEPTH, HEAD_DIM)),
        'w_br_pool': nrm((DEPTH, POOL_WIDTH, D_MODEL), POOL_WIDTH ** -0.5),
        'w_br_hg': nrm((DEPTH, HG_VW, D_MODEL), HG_VW ** -0.5),
        'w_br_att': nrm((DEPTH, ATT_QW, D_MODEL), ATT_QW ** -0.5),
        'w_out': nrm((DEPTH, D_MODEL, D_MODEL), D_MODEL ** -0.5),
        'g_ffn': gain((DEPTH, D_MODEL)),
        'w_up': nrm((DEPTH, D_MODEL, 2 * D_FF), D_MODEL ** -0.5),
        'conv_w': nrm((DEPTH, CONV_W, 2 * D_FF), CONV_W ** -0.5),
        'conv_b': nrm((DEPTH, 2 * D_FF), 0.01),
        'w_down': nrm((DEPTH, D_FF, D_MODEL), D_FF ** -0.5),
        'g_ple': gain((DEPTH, D_MODEL)),
        'w_ple_gate': nrm((DEPTH, D_MODEL, D_MODEL), D_MODEL ** -0.5),
        'w_ple': nrm((DEPTH, PLE_DIM, D_MODEL), PLE_DIM ** -0.5),
        'g_final': gain((D_MODEL,)),
    }


def reference(x_prompt, x_sample, p_prompt, p_sample, g_mix, w_in, pool_w, pool_scale, lb_raw_f, lb_raw_b,
              hg_onorm, g_q, g_k, w_br_pool, w_br_hg, w_br_att, w_out, g_ffn, w_up, conv_w, conv_b, w_down,
              g_ple, w_ple_gate, w_ple, g_final):
    lb_f = _lower_bound(lb_raw_f)
    lb_b = _lower_bound(lb_raw_b)
    weights = (g_mix, w_in, pool_w, pool_scale, lb_f, lb_b, hg_onorm, g_q, g_k, w_br_pool, w_br_hg, w_br_att,
               w_out, g_ffn, w_up, conv_w, conv_b, w_down, g_ple, w_ple_gate, w_ple, g_final)
    cos_p, sin_p = _axial_rope_tables(x_prompt.shape[1])
    cos_s, sin_s = _axial_rope_tables(x_sample.shape[1])
    y_prompt = _trunk(x_prompt, p_prompt, cos_p, sin_p, *weights)
    y_sample = _trunk(x_sample, p_sample, cos_s, sin_s, *weights)
    return (y_prompt, y_sample)
```

```cpp
#include <hip/hip_runtime.h>
#include <hip/hip_cooperative_groups.h>
#include <cstdio>
#include <cstdint>
namespace cg = cooperative_groups;

#ifndef ONE_LAUNCH
#define ONE_LAUNCH 1
#endif

#define LAS __attribute__((address_space(3)))
typedef unsigned short bf16_t;
typedef short bf16x8 __attribute__((ext_vector_type(8)));
typedef short s16x4 __attribute__((ext_vector_type(4)));
typedef float f32x4 __attribute__((ext_vector_type(4)));
typedef float f32x2 __attribute__((ext_vector_type(2)));
typedef float f32x16 __attribute__((ext_vector_type(16)));
typedef unsigned u32x4 __attribute__((ext_vector_type(4)));
typedef unsigned u32x2 __attribute__((ext_vector_type(2)));

constexpr int DM = 1024, DEPTH = 4, PLE = 256, DFF = 2816, DFF2 = 5632;
constexpr int OFF_POOL = 0, OFF_HQ = 512, OFF_HFF = 1024, OFF_HFB = 1536, OFF_HI = 2048, OFF_HG = 2560, OFF_AQ = 3072, OFF_AK = 4096, OFF_AV = 4352, OFF_GATE = 4608, INW = 7680;
constexpr int T = 16384;
constexpr int NGROUP = 3;
constexpr float EPS = 1e-6f;
constexpr int XBLD = 1280;
constexpr int YLD = 2048;
constexpr int WPGLD = 1280;

constexpr size_t MiB = 1u << 20;
constexpr size_t WS_CS = 0;
constexpr size_t WS_LB = 64 * 1024;
constexpr size_t WS_WIN = 1 * MiB;
constexpr size_t WS_WCAT = 61 * MiB;
constexpr size_t WS_WOUT = 77 * MiB;
constexpr size_t WS_WUP = 85 * MiB;
constexpr size_t WS_WDOWN = 129 * MiB;
constexpr size_t WS_WPG = 151 * MiB;
constexpr size_t WS_XB0 = 161 * MiB;
constexpr size_t WS_XB1 = 201 * MiB;
constexpr size_t WS_RSS = 241 * MiB;
constexpr size_t WS_Z = 243 * MiB;
constexpr size_t WS_YCAT = 483 * MiB;
constexpr size_t WS_MERGED = 547 * MiB;
constexpr size_t WS_ST = 579 * MiB;
constexpr size_t WS_VT = 643 * MiB;
constexpr size_t WS_DEC = 651 * MiB;
constexpr size_t WS_END = 652 * MiB;

constexpr int LDS_BYTES = 153600;

typedef __bf16 bf16x2_t __attribute__((ext_vector_type(2)));
__device__ __forceinline__ unsigned cvt_pk(float lo, float hi) { f32x2 v = {lo, hi}; bf16x2_t b = __builtin_convertvector(v, bf16x2_t); return __builtin_bit_cast(unsigned, b); }
__device__ __forceinline__ float bf2f(bf16_t h) { return __uint_as_float((unsigned)h << 16); }
__device__ __forceinline__ float bflo(unsigned w) { return __uint_as_float(w << 16); }
__device__ __forceinline__ float bfhi(unsigned w) { return __uint_as_float(w & 0xffff0000u); }
__device__ __forceinline__ bf16_t f2bf(float f) { return (bf16_t)(cvt_pk(f, 0.f) & 0xffffu); }
__device__ __forceinline__ float frcp(float x) { return __builtin_amdgcn_rcpf(x); }
__device__ __forceinline__ float sigm(float x) { return frcp(1.f + __expf(-x)); }
__device__ __forceinline__ int crow(int r, int hi) { return (r & 3) + 8 * (r >> 2) + 4 * hi; }
__device__ __forceinline__ f32x16 mfma32(bf16x8 x, bf16x8 y, f32x16 c) { return __builtin_amdgcn_mfma_f32_32x32x16_bf16(x, y, c, 0, 0, 0); }
__device__ __forceinline__ float wave_sum(float v) {
#pragma unroll
    for (int o = 1; o < 64; o <<= 1) v += __shfl_xor(v, o);
    return v;
}

__device__ __forceinline__ float gelu_tanh_e(float a) { const float e = __builtin_amdgcn_exp2f(a * (2.3022081984f + 0.1029432396f * (a * a))); return a - a * frcp(e + 1.f);   }

constexpr size_t WS_RSS_OFF = 241u * 1048576u, WS_ACT_OFF = 483u * 1048576u, WS_EB_OFF = (579u + 32u) * 1048576u;
extern __shared__ __attribute__((aligned(16))) unsigned char g_lds[];
namespace pg8 {
constexpr int BM = 256, BK = 64, HALF = 128, HTB = HALF * BK * 2, STAGE_BYTES = 8 * HTB, NXCD = 8, WGM = 8;
__host__ __device__ __forceinline__ int lds_byte(int r, int c) { const int st = (r >> 4) * 2 + (c >> 5), rr = r & 15, cc = c & 31, ob = rr * 64 + cc * 2; return st * 1024 + (ob ^ (((ob >> 9) & 1) << 5)); }
__host__ __device__ __forceinline__ void stage_rc(int b, int& R, int& C) { const int st = b / 1024, sb = b % 1024, swz = sb ^ (((sb >> 9) & 1) << 5); R = (st >> 1) * 16 + swz / 64; C = (st & 1) * 32 + (swz % 64) / 2; }
__host__ __device__ __forceinline__ int perm32(int rho) { const int n = rho >> 4, i = rho & 15; return 8 * (i >> 2) + 4 * n + (i & 3); }

struct Unit { int pm, pn, br, koff, nt; };
struct Gemm { const bf16_t* A; const bf16_t* Bt; int lda, ldb; };

template <int N_, int NBR, int K0, int T0, int K1, int T1, int K2, int T2>
struct Sched {
    int G, c;
    static constexpr int nM = 16384 / BM, nN = N_ / BM, nwg = nM * nN;
    __device__ __forceinline__ bool next(int i, Unit& u) const {
        const int ti = i / NBR, br = i - ti * NBR;
        const int L = ti * G + c; if (L >= nwg) return false;
        int wgid = L; { constexpr int q = nwg / NXCD, r = nwg % NXCD; const int xcd = wgid % NXCD, off = wgid / NXCD; wgid = (xcd < r ? xcd * (q + 1) : r * (q + 1) + (xcd - r) * q) + off; }
        constexpr int nig = WGM * nN; const int gid = wgid / nig, fm = gid * WGM, gsz = (nM - fm) < WGM ? (nM - fm) : WGM;
        u.pm = fm + ((wgid % nig) % gsz); u.pn = (wgid % nig) / gsz; u.br = br;
        u.koff = br == 0 ? K0 : (br == 1 ? K1 : K2); u.nt = br == 0 ? T0 : (br == 1 ? T1 : T2);
        return true;
    }
};

template <class Epi, class SchedT>
__device__ __forceinline__ void gemm_phase(const int TIDX, const int BIDX, const int GDIM, LAS unsigned char* lds, const Gemm g, const SchedT& S, const Epi& E) {
    const int tid = TIDX, wid = __builtin_amdgcn_readfirstlane(tid >> 6), lane = tid & 63, wr = wid >> 2, wc = wid & 3, fr = lane & 15, fq = lane >> 4;
    unsigned voffA[2], voffB[2];
#pragma unroll
    for (int i = 0; i < 2; ++i) { int R, C; stage_rc(tid * 16 + i * 8192, R, C); const int Rb = (R & ~31) + perm32(R & 31);
        voffA[i] = (unsigned)(R * g.lda + C) * 2u; voffB[i] = (unsigned)(Rb * g.ldb + C) * 2u; }
    const size_t kstep = (size_t)(BK * 2);
    const size_t hstepA = (size_t)HALF * g.lda * 2, hstepB = (size_t)HALF * g.ldb * 2;
    const size_t tstepA = 2 * hstepA, tstepB = 2 * hstepB;
    const unsigned ldsw = (unsigned)wid * 1024u;
    const int aoff = lds_byte(wr * 64 + fr, fq * 8), boff = lds_byte(wc * 32 + fr, fq * 8);
#define PG8_SA(b, h) (((b) * 2 + (h)) * HTB)
#define PG8_SB(b, h) ((4 + (b) * 2 + (h)) * HTB)
#define PG8_STAGE(bufoff, gbase, voff) do { _Pragma("unroll") for (int _i = 0; _i < 2; ++_i) \
        __builtin_amdgcn_global_load_lds((const unsigned*)((const char*)(gbase) + (voff)[_i]), (LAS unsigned*)(lds + (bufoff) + ldsw + _i * 8192), 16, 0, 0); } while (0)
#define PG8_LDA(dst, b, h) do { _Pragma("unroll") for (int m = 0; m < 4; ++m) _Pragma("unroll") for (int k = 0; k < 2; ++k) dst[m][k] = *(const LAS bf16x8*)(lds + PG8_SA(b, h) + aoff + m * 2048 + k * 1024); } while (0)
#define PG8_LDB(dst, b, h) do { _Pragma("unroll") for (int n = 0; n < 2; ++n) _Pragma("unroll") for (int k = 0; k < 2; ++k) dst[n][k] = *(const LAS bf16x8*)(lds + PG8_SB(b, h) + boff + n * 2048 + k * 1024); } while (0)
#define PG8_MMA(ai, bj, At, Bt) do { __builtin_amdgcn_s_setprio(1); _Pragma("unroll") for (int m = 0; m < 4; ++m) _Pragma("unroll") for (int n = 0; n < 2; ++n) _Pragma("unroll") for (int k = 0; k < 2; ++k) \
        acc[ai][bj][m][n] = __builtin_amdgcn_mfma_f32_16x16x32_bf16(Bt[n][k], At[m][k], acc[ai][bj][m][n], 0, 0, 0); __builtin_amdgcn_s_setprio(0); } while (0)
#define PG8_WAIT_V(n) asm volatile("s_waitcnt vmcnt(" #n ")" ::: "memory")
#define PG8_WAIT_L(n) asm volatile("s_waitcnt lgkmcnt(" #n ")" ::: "memory")
#define PG8_BAR __builtin_amdgcn_s_barrier()
#define PG8_SCHED __builtin_amdgcn_sched_barrier(0)
    Unit cur, nxt; int ui = 0;
    if (!S.next(0, cur)) return;
    f32x4 acc[2][2][4][2];
#pragma unroll
    for (int a = 0; a < 2; ++a)
#pragma unroll
        for (int b = 0; b < 2; ++b)
#pragma unroll
            for (int m = 0; m < 4; ++m)
#pragma unroll
                for (int n = 0; n < 2; ++n) acc[a][b][m][n] = (f32x4){0.f, 0.f, 0.f, 0.f};
    bf16x8 At[4][2], B0[2][2], B1[2][2];
    const char* cA = (const char*)g.A + (size_t)cur.pm * tstepA + (size_t)cur.koff * 2; const char* cB = (const char*)g.Bt + (size_t)cur.pn * tstepB + (size_t)cur.koff * 2;
    PG8_STAGE(PG8_SB(0, 0), cB, voffB); PG8_STAGE(PG8_SB(0, 1), cB + hstepB, voffB); PG8_STAGE(PG8_SA(0, 0), cA, voffA); PG8_STAGE(PG8_SA(0, 1), cA + hstepA, voffA);
    if (wr == 1) PG8_BAR;
    PG8_WAIT_V(2); PG8_BAR;
    PG8_STAGE(PG8_SB(1, 0), cB + kstep, voffB); PG8_STAGE(PG8_SA(1, 0), cA + kstep, voffA); PG8_STAGE(PG8_SB(1, 1), cB + hstepB + kstep, voffB);
    PG8_WAIT_V(6); PG8_BAR;
    for (;;) {
        const bool has_next = S.next(ui + 1, nxt);
        const int nt = cur.nt;
        const char* nA = has_next ? (const char*)g.A + (size_t)nxt.pm * tstepA + (size_t)nxt.koff * 2 : cA; const char* nB = has_next ? (const char*)g.Bt + (size_t)nxt.pn * tstepB + (size_t)nxt.koff * 2 : cB;
        for (int t = 0; t < nt; t += 2) {
            const bool last = (t == nt - 2);
            const char* a1 = cA + (size_t)(t + 1) * kstep;
            const char* a2 = last ? nA : cA + (size_t)(t + 2) * kstep; const char* b2 = last ? nB : cB + (size_t)(t + 2) * kstep;
            const char* a3 = a2 + kstep; const char* b3 = b2 + kstep;
            PG8_LDB(B0, 0, 0); PG8_LDB(B1, 0, 1); PG8_SCHED; PG8_LDA(At, 0, 0); PG8_STAGE(PG8_SA(1, 1), a1 + hstepA, voffA);
            PG8_WAIT_V(8); PG8_WAIT_L(0); PG8_BAR; PG8_MMA(0, 0, At, B0); PG8_MMA(0, 1, At, B1); PG8_BAR; PG8_SCHED;
            PG8_LDA(At, 0, 1); PG8_STAGE(PG8_SB(0, 0), b2, voffB); PG8_STAGE(PG8_SB(0, 1), b2 + hstepB, voffB); PG8_STAGE(PG8_SA(0, 0), a2, voffA);
            PG8_WAIT_V(8); PG8_WAIT_L(0); PG8_BAR; PG8_MMA(1, 0, At, B0); PG8_MMA(1, 1, At, B1); PG8_BAR; PG8_SCHED;
            PG8_LDB(B0, 1, 0); PG8_LDB(B1, 1, 1); PG8_SCHED; PG8_LDA(At, 1, 0); PG8_STAGE(PG8_SA(0, 1), a2 + hstepA, voffA);
            PG8_WAIT_V(8); PG8_WAIT_L(0); PG8_BAR; PG8_MMA(0, 0, At, B0); PG8_MMA(0, 1, At, B1); PG8_BAR; PG8_SCHED;
            PG8_LDA(At, 1, 1); PG8_STAGE(PG8_SB(1, 0), b3, voffB); PG8_STAGE(PG8_SB(1, 1), b3 + hstepB, voffB); PG8_STAGE(PG8_SA(1, 0), a3, voffA);
            PG8_WAIT_V(8); PG8_WAIT_L(0); PG8_BAR; PG8_MMA(1, 0, At, B0); PG8_MMA(1, 1, At, B1); PG8_BAR; PG8_SCHED;
        }
        if (wr == 0) PG8_BAR;
        E(acc, cur, wr, wc, fr, fq);
        if (!has_next) break;
#pragma unroll
        for (int a = 0; a < 2; ++a)
#pragma unroll
            for (int b = 0; b < 2; ++b)
#pragma unroll
                for (int m = 0; m < 4; ++m)
#pragma unroll
                    for (int n = 0; n < 2; ++n) acc[a][b][m][n] = (f32x4){0.f, 0.f, 0.f, 0.f};
        cur = nxt; cA = nA; cB = nB; ++ui;
        if (wr == 1) PG8_BAR;
    }
    PG8_WAIT_V(0);
    PG8_BAR;
#undef PG8_SA
#undef PG8_SB
#undef PG8_STAGE
#undef PG8_LDA
#undef PG8_LDB
#undef PG8_MMA
#undef PG8_WAIT_V
#undef PG8_WAIT_L
#undef PG8_BAR
#undef PG8_SCHED
}

__device__ __forceinline__ float row_rinv(const float* rss, int row) {
    const f32x4* p = (const f32x4*)(rss + (size_t)row * 16);
    const f32x4 a = p[0], b = p[1], c = p[2], d = p[3];
    const float s = ((a[0] + a[1]) + (a[2] + a[3])) + ((b[0] + b[1]) + (b[2] + b[3])) + ((c[0] + c[1]) + (c[2] + c[3])) + ((d[0] + d[1]) + (d[2] + d[3]));
    return rsqrtf(s * (1.0f / DM) + EPS);
}
__device__ __forceinline__ float row_rinv_q(const float* rss, int row, int fq) {
    const f32x4 a = ((const f32x4*)(rss + (size_t)row * 16))[fq];
    float s = (a[0] + a[1]) + (a[2] + a[3]);
    s += __shfl_xor(s, 16); s += __shfl_xor(s, 32);
    return rsqrtf(s * (1.0f / DM) + EPS);
}
struct EpiScale {
    bf16_t* O; int ldc; const float* rss; int sig_pn;
    __device__ __forceinline__ void operator()(const f32x4 (&acc)[2][2][4][2], const Unit& u, int wr, int wc, int fr, int fq) const {
        const int col0 = u.pn * BM + wc * 32 + 8 * fq; const bool sg = u.pn >= sig_pn;
#pragma unroll
        for (int ai = 0; ai < 2; ++ai)
#pragma unroll
            for (int m = 0; m < 4; ++m) { const int row = u.pm * BM + ai * HALF + wr * 64 + m * 16 + fr; const float r = row_rinv(rss, row);
                bf16_t* rowp = O + (size_t)row * ldc + col0;
#pragma unroll
                for (int bj = 0; bj < 2; ++bj) { f32x4 v0 = acc[ai][bj][m][0] * r, v1 = acc[ai][bj][m][1] * r;
                    if (sg) {
#pragma unroll
                        for (int e = 0; e < 4; ++e) { v0[e] = sigm(v0[e]); v1[e] = sigm(v1[e]); } }
                    u32x4 w; w.x = cvt_pk(v0[0], v0[1]); w.y = cvt_pk(v0[2], v0[3]); w.z = cvt_pk(v1[0], v1[1]); w.w = cvt_pk(v1[2], v1[3]);
                    __builtin_nontemporal_store(w, (u32x4*)(rowp + bj * HALF)); }
                asm volatile("" ::: "memory"); }
    }
};
struct EpiMerge {
    const bf16_t* Z; bf16_t* facc; bf16_t* merged;
    __device__ __forceinline__ void operator()(const f32x4 (&acc)[2][2][4][2], const Unit& u, int wr, int wc, int fr, int fq) const {
        const int col0 = u.pn * BM + wc * 32 + 8 * fq;
#pragma unroll
        for (int ai = 0; ai < 2; ++ai)
#pragma unroll
            for (int m = 0; m < 4; ++m) { const int row = u.pm * BM + ai * HALF + wr * 64 + m * 16 + fr;
#pragma unroll
                for (int bj = 0; bj < 2; ++bj) { const int col = col0 + bj * HALF;
                    const u32x4 gw = *(const u32x4*)(Z + (size_t)row * INW + OFF_GATE + u.br * DM + col);
                    f32x4 v0 = acc[ai][bj][m][0], v1 = acc[ai][bj][m][1];
                    v0[0] *= bflo(gw.x); v0[1] *= bfhi(gw.x); v0[2] *= bflo(gw.y); v0[3] *= bfhi(gw.y);
                    v1[0] *= bflo(gw.z); v1[1] *= bfhi(gw.z); v1[2] *= bflo(gw.w); v1[3] *= bfhi(gw.w);
                    bf16_t* fp = facc + (size_t)row * DM + col;
                    if (u.br > 0) { const u32x4 pw = *(const u32x4*)fp; v0[0] += bflo(pw.x); v0[1] += bfhi(pw.x); v0[2] += bflo(pw.y); v0[3] += bfhi(pw.y); v1[0] += bflo(pw.z); v1[1] += bfhi(pw.z); v1[2] += bflo(pw.w); v1[3] += bfhi(pw.w); }
                    if (u.br < 2) { u32x4 w; w.x = cvt_pk(v0[0], v0[1]); w.y = cvt_pk(v0[2], v0[3]); w.z = cvt_pk(v1[0], v1[1]); w.w = cvt_pk(v1[2], v1[3]); *(u32x4*)fp = w; }
                    else { u32x4 w; w.x = cvt_pk(v0[0], v0[1]); w.y = cvt_pk(v0[2], v0[3]); w.z = cvt_pk(v1[0], v1[1]); w.w = cvt_pk(v1[2], v1[3]);
                        *(u32x4*)(merged + (size_t)row * DM + col) = w; } }
                asm volatile("" ::: "memory"); }
    }
};
template <int MODE> struct EpiX {
    const bf16_t* baseb; float* out; bf16_t* xb; float* rss_out; const float* rss_in; bf16_t* facc; int wout;
    __device__ __forceinline__ void operator()(const f32x4 (&acc)[2][2][4][2], const Unit& u, int wr, int wc, int fr, int fq) const {
        const int col0 = u.pn * BM + wc * 32 + 8 * fq;
#pragma unroll
        for (int ai = 0; ai < 2; ++ai)
#pragma unroll
            for (int m = 0; m < 4; ++m) { const int row = u.pm * BM + ai * HALF + wr * 64 + m * 16 + fr;
                if (MODE == 1 && u.br == 0) {
#pragma unroll
                    for (int bj = 0; bj < 2; ++bj) { bf16_t* fp = facc + (size_t)row * DM + col0 + bj * HALF; const f32x4 a0 = acc[ai][bj][m][0], a1 = acc[ai][bj][m][1]; u32x4 w; w.x = cvt_pk(a0[0], a0[1]); w.y = cvt_pk(a0[2], a0[3]); w.z = cvt_pk(a1[0], a1[1]); w.w = cvt_pk(a1[2], a1[3]); *(u32x4*)fp = w; }
                } else {
                    float r = 1.f; if (MODE == 1) r = row_rinv(rss_in, row);
                    float ss = 0.f;
#pragma unroll
                    for (int bj = 0; bj < 2; ++bj) { const int col = col0 + bj * HALF; const size_t off = (size_t)row * DM + col;
                        f32x4 v0 = acc[ai][bj][m][0], v1 = acc[ai][bj][m][1];
                        if (MODE == 1) { const u32x4 pw = *(const u32x4*)(facc + off); const f32x4 p0 = (f32x4){bflo(pw.x), bfhi(pw.x), bflo(pw.y), bfhi(pw.y)}, p1 = (f32x4){bflo(pw.z), bfhi(pw.z), bflo(pw.w), bfhi(pw.w)};
#pragma unroll
                            for (int e = 0; e < 4; ++e) { v0[e] = sigm(v0[e] * r) * p0[e]; v1[e] = sigm(v1[e] * r) * p1[e]; } }
                        const u32x4 bw = *(const u32x4*)(baseb + (size_t)row * XBLD + col);
                        v0[0] += bflo(bw.x); v0[1] += bfhi(bw.x); v0[2] += bflo(bw.y); v0[3] += bfhi(bw.y); v1[0] += bflo(bw.z); v1[1] += bfhi(bw.z); v1[2] += bflo(bw.w); v1[3] += bfhi(bw.w);
                        if (wout) { *(f32x4*)(out + off) = v0; *(f32x4*)(out + off + 4) = v1; }
                        ss += (v0[0] * v0[0] + v0[1] * v0[1]) + (v0[2] * v0[2] + v0[3] * v0[3]) + (v1[0] * v1[0] + v1[1] * v1[1]) + (v1[2] * v1[2] + v1[3] * v1[3]);
                        u32x4 w; w.x = cvt_pk(v0[0], v0[1]); w.y = cvt_pk(v0[2], v0[3]); w.z = cvt_pk(v1[0], v1[1]); w.w = cvt_pk(v1[2], v1[3]);
                        *(u32x4*)(xb + (size_t)row * XBLD + col) = w; }
                    ss += __shfl_xor(ss, 16); ss += __shfl_xor(ss, 32);
                    if (fq == 0) rss_out[(size_t)row * 16 + u.pn * 4 + wc] = ss;
                }
                asm volatile("" ::: "memory"); }
    }
};
#define PIN_ACC_HALF(A) asm volatile("" : "+v"(acc[A][0][0][0]), "+v"(acc[A][0][0][1]), "+v"(acc[A][0][1][0]), "+v"(acc[A][0][1][1]), "+v"(acc[A][0][2][0]), "+v"(acc[A][0][2][1]), "+v"(acc[A][0][3][0]), "+v"(acc[A][0][3][1]), \
    "+v"(acc[A][1][0][0]), "+v"(acc[A][1][0][1]), "+v"(acc[A][1][1][0]), "+v"(acc[A][1][1][1]), "+v"(acc[A][1][2][0]), "+v"(acc[A][1][2][1]), "+v"(acc[A][1][3][0]), "+v"(acc[A][1][3][1]))
#define PIN_ACC() do { PIN_ACC_HALF(0); PIN_ACC_HALF(1); } while (0)
struct EpiUp {
    unsigned char* ws; int layer, rsel;
    __device__ __forceinline__ void operator()(f32x4 (&acc)[2][2][4][2], const Unit& u, int wr, int wc, int fr, int fq) const {
        { const int lane_ = (int)__builtin_amdgcn_mbcnt_hi(~0u, __builtin_amdgcn_mbcnt_lo(~0u, 0u)); fr = lane_ & 15; fq = lane_ >> 4; }
        asm volatile("" : "+v"(fr), "+v"(fq));
        const unsigned row0 = (unsigned)(u.pm * BM + wr * 64 + fr);
        typedef __attribute__((address_space(4))) const unsigned char* kap_t; const kap_t ka_ = (kap_t)__builtin_amdgcn_kernarg_segment_ptr();
        const float* cw = *(const float* const volatile __attribute__((address_space(4)))*)(ka_ + 8 * 19) + (size_t)layer * 3 * DFF2;
        const float* cb = *(const float* const volatile __attribute__((address_space(4)))*)(ka_ + 8 * 20) + (size_t)layer * DFF2;
        unsigned char* ldsx = g_lds + 132096;
        const char* rssb = (const char*)(ws + WS_RSS_OFF + (size_t)rsel * (16384u * 64u)); char* actb = (char*)(ws + WS_ACT_OFF); char* ebb = (char*)(ws + WS_EB_OFF);
        {
            float* rtab = (float*)(g_lds + 148480 + (wr * 4 + wc) * 512);
            const unsigned lrow = (unsigned)(u.pm * BM + wr * 64) + (unsigned)(fq * 16 + fr);
            rtab[fq * 16 + fr] = row_rinv((const float*)rssb, (int)lrow); rtab[64 + fq * 16 + fr] = row_rinv((const float*)rssb, (int)(lrow + HALF));
            asm volatile("s_waitcnt lgkmcnt(0)" ::: "memory");
#pragma unroll
            for (int ai = 0; ai < 2; ++ai)
#pragma unroll
                for (int m = 0; m < 4; ++m) { const float r = rtab[ai * 64 + m * 16 + fr];
#pragma unroll
                    for (int bj = 0; bj < 2; ++bj) { acc[ai][bj][m][0] *= r; acc[ai][bj][m][1] *= r; } } }
        PIN_ACC();
        unsigned char* sl = ldsx + (wr * 4 + wc) * 2048 + fr * 32 + fq * 8;
#pragma unroll
        for (int n = 0; n < 2; ++n) {
            const unsigned ch = (unsigned)(u.pn * 128 + wc * 32 + 8 * fq + 4 * n);
#pragma unroll
            for (int bj = 0; bj < 2; ++bj) {
                const char* cwb = (const char*)cw; const unsigned coff = (bj * DFF + ch) * 4u;
                const f32x4 w0 = *(const f32x4*)(cwb + coff), w1 = *(const f32x4*)(cwb + coff + DFF2 * 4u), w2 = *(const f32x4*)(cwb + coff + 2u * DFF2 * 4u), bb = *(const f32x4*)((const char*)cb + coff);
#pragma unroll
                for (int ai = 0; ai < 2; ++ai) {
                    const unsigned blk = (unsigned)(u.pm * 4 + ai * 2 + wr);
                    u32x2 pk[4];
#pragma unroll
                    for (int m = 0; m < 4; ++m) { const f32x4 x = acc[ai][bj][m][n]; pk[m].x = cvt_pk(x[0], x[1]); pk[m].y = cvt_pk(x[2], x[3]); *(u32x2*)(sl + m * 512) = pk[m]; }
                    { const unsigned dummy = 256u * 4u * DFF2 * 2u + (unsigned)(fq * 16 + fr) * 8u;
                      const unsigned e0 = fr < 2 ? ((blk * 4u + (unsigned)fr) * DFF2 + bj * DFF + ch) * 2u : dummy, e3 = fr >= 14 ? ((blk * 4u + (unsigned)(fr - 12)) * DFF2 + bj * DFF + ch) * 2u : dummy;
                      *(u32x2*)(ebb + e0) = pk[0]; *(u32x2*)(ebb + e3) = pk[3]; }
                    asm volatile("s_waitcnt lgkmcnt(0)" ::: "memory");
#pragma unroll
                    for (int m = 0; m < 4; ++m) { const f32x4 x = acc[ai][bj][m][n];
                        const u32x2 pw = *(const u32x2*)(sl + m * 512 - 32), nw = *(const u32x2*)(sl + m * 512 + 32);
                        const f32x4 pv = (f32x4){bflo(pw.x), bfhi(pw.x), bflo(pw.y), bfhi(pw.y)}, nv = (f32x4){bflo(nw.x), bfhi(nw.x), bflo(nw.y), bfhi(nw.y)};
                        acc[ai][bj][m][n] = pv * w0 + x * w1 + nv * w2 + bb; }
                    asm volatile("s_waitcnt lgkmcnt(0)" ::: "memory");
                    PIN_ACC();
                }
            }
#pragma unroll
            for (int ai = 0; ai < 2; ++ai)
#pragma unroll
                for (int m = 0; m < 4; ++m) { const unsigned row = row0 + ai * HALF + m * 16;
                    const f32x4 ca = acc[ai][0][m][n], cg = acc[ai][1][m][n];
                    { u32x2 w;     w.x = cvt_pk(gelu_tanh_e(ca[0]) * cg[0], gelu_tanh_e(ca[1]) * cg[1]); w.y = cvt_pk(gelu_tanh_e(ca[2]) * cg[2], gelu_tanh_e(ca[3]) * cg[3]);
                        *(u32x2*)(actb + (row * DFF + ch) * 2u) = w; } }
        }
    }
};
}

struct Params { const float* in[26]; float* out; unsigned char* ws; int lo, hi; };

__device__ __forceinline__ void transpose_item(const float* W, int K, int N, bf16_t* WT, int ldwt, int kdst, const float* gk, float sc_lo, int nlo, int nhi, float* scr, int item, int lane, bool permup = false) {
    const int nblk = N / 32, kb = item / nblk, nb = item % nblk, k0 = 64 * kb, n0 = 32 * nb;
    const float sc = (n0 >= nlo && n0 < nhi) ? sc_lo : 1.f;
#pragma unroll 8
    for (int i = 0; i < 32; ++i) { const int kk = 2 * i + (lane >> 5); float g = gk ? gk[k0 + kk] : 1.f; scr[kk * 33 + (lane & 31)] = W[(size_t)(k0 + kk) * N + n0 + (lane & 31)] * g * sc; }
    asm volatile("s_waitcnt lgkmcnt(0)" ::: "memory");
    const int c = lane & 7;
    int drow0 = n0; if (permup) { const int isg = n0 >= DFF ? 1 : 0, chn = n0 - isg * DFF; drow0 = (chn >> 7) * 256 + isg * 128 + (chn & 127); }
#pragma unroll
    for (int j = 0; j < 4; ++j) { const int n = (lane >> 3) + 8 * j; const float* s = scr + (8 * c) * 33 + n;
        u32x4 o; o.x = cvt_pk(s[0 * 33], s[1 * 33]); o.y = cvt_pk(s[2 * 33], s[3 * 33]); o.z = cvt_pk(s[4 * 33], s[5 * 33]); o.w = cvt_pk(s[6 * 33], s[7 * 33]);
        *(u32x4*)(WT + (size_t)(drow0 + n) * ldwt + kdst + k0 + 8 * c) = o; }
    asm volatile("s_waitcnt lgkmcnt(0)" ::: "memory");
}

typedef __attribute__((address_space(4))) const unsigned char* kaptr_t;
#define KIN0(i) (*(const float* const volatile __attribute__((address_space(4)))*)(ka + 8 * (i)))
__device__ __forceinline__ void phase0(const int TIDX, const int BIDX, const int GDIM, kaptr_t ka, unsigned char* lds) {
    const int tid = TIDX, lane = tid & 63, wave = tid >> 6;
    unsigned char* ws = *(unsigned char* const volatile __attribute__((address_space(4)))*)(ka + 8 * 27);
    const int gthreads = GDIM * 512, gtid = BIDX * 512 + tid;
    if (gtid < 128 * 16) { const int p = gtid >> 4, i = gtid & 15; const float invf = exp2f(-(float)i * (13.287712379549449f / 16.0f)); const float ang = (float)p * invf;
        ((f32x2*)(ws + WS_CS))[gtid] = (f32x2){cosf(ang), sinf(ang)}; }
    if (gtid >= 2048 && gtid < 2048 + 1024) { const int q = gtid - 2048, dir = q >> 9, ch = q & 511; const float* raw = KIN0(dir ? 9 : 8);
        float v[4], mx = -1e30f;
#pragma unroll
        for (int l = 0; l < 4; ++l) { v[l] = raw[l * 512 + ch]; mx = fmaxf(mx, v[l]); }
        float s = 0.f;
#pragma unroll
        for (int l = 0; l < 4; ++l) { v[l] = expf(v[l] - mx); s += v[l]; }
        float run = 0.f; float* LB = (float*)(ws + WS_LB);
#pragma unroll
        for (int l = 0; l < 4; ++l) { if (l > 0) run += v[l] / s; LB[(l * 2 + dir) * 512 + ch] = run; } }
    float* scr = (float*)(lds + wave * 16384);
    const int gw = BIDX * 8 + wave, NGW = GDIM * 8;
    constexpr int I_IN = 16 * 240, I_UP = 16 * 176, I_DN = 44 * 32, I_HG = 8 * 32, I_AT = 16 * 32, I_OUT = 16 * 32, I_PG = 16 * 32, I_PL = 4 * 32;
    constexpr int PER_L = I_IN + I_UP + I_DN + I_HG + I_AT + I_OUT + I_PG + I_PL;
    for (int it = gw; it < 4 * PER_L; it += NGW) {
        const int l = it / PER_L; int r = it % PER_L;
        if (r < I_IN) { transpose_item(KIN0(5) + (size_t)l * DM * INW, DM, INW, (bf16_t*)(ws + WS_WIN) + (size_t)l * INW * DM, DM, 0, KIN0(4) + l * DM, 0.08838834764831845f, OFF_HQ, OFF_HFF, scr, r, lane); continue; } r -= I_IN;
        if (r < I_UP) { transpose_item(KIN0(18) + (size_t)l * DM * DFF2, DM, DFF2, (bf16_t*)(ws + WS_WUP) + (size_t)l * DFF2 * DM, DM, 0, KIN0(17) + l * DM, 1.f, 0, 0, scr, r, lane, true); continue; } r -= I_UP;
        if (r < I_DN) { transpose_item(KIN0(21) + (size_t)l * DFF * DM, DFF, DM, (bf16_t*)(ws + WS_WDOWN) + (size_t)l * DM * DFF, DFF, 0, nullptr, 1.f, 0, 0, scr, r, lane); continue; } r -= I_DN;
        if (r < I_HG) { transpose_item(KIN0(14) + (size_t)l * 512 * DM, 512, DM, (bf16_t*)(ws + WS_WCAT) + (size_t)l * DM * YLD, YLD, 512, nullptr, 1.f, 0, 0, scr, r, lane); continue; } r -= I_HG;
        if (r < I_AT) { transpose_item(KIN0(15) + (size_t)l * DM * DM, DM, DM, (bf16_t*)(ws + WS_WCAT) + (size_t)l * DM * YLD, YLD, 1024, nullptr, 1.f, 0, 0, scr, r, lane); continue; } r -= I_AT;
        if (r < I_OUT) { transpose_item(KIN0(16) + (size_t)l * DM * DM, DM, DM, (bf16_t*)(ws + WS_WOUT) + (size_t)l * DM * DM, DM, 0, nullptr, 1.f, 0, 0, scr, r, lane); continue; } r -= I_OUT;
        if (r < I_PG) { transpose_item(KIN0(23) + (size_t)l * DM * DM, DM, DM, (bf16_t*)(ws + WS_WPG) + (size_t)l * DM * WPGLD, WPGLD, 0, KIN0(22) + l * DM, 1.f, 0, 0, scr, r, lane); continue; } r -= I_PG;
        transpose_item(KIN0(24) + (size_t)l * PLE * DM, PLE, DM, (bf16_t*)(ws + WS_WPG) + (size_t)l * DM * WPGLD, WPGLD, 1024, nullptr, 1.f, 0, 0, scr, r, lane);
    }
    for (int o = gtid; o < 4 * 512 * 1024; o += gthreads) {
        const int n = o & 1023, gc = (o >> 10) & 511, l = o >> 19, g = gc >> 7;
        const float* pw = KIN0(6) + ((size_t)l * 512 + gc) * 128; const float* sc = KIN0(7) + l * 512 + g * 128; const float* wb = KIN0(13) + ((size_t)l * 512 + g * 128) * DM + n;
        float s = 0.f;
#pragma unroll 8
        for (int d = 0; d < 128; ++d) s += pw[d] * sc[d] * wb[(size_t)d * DM];
        ((bf16_t*)(ws + WS_WCAT))[((size_t)l * DM + n) * YLD + gc] = f2bf(s);
    }
}

__device__ __forceinline__ void group_init(const int TIDX, const int BIDX, const int GDIM, const float* xin, bf16_t* xb, float* rss) {
    const int lane = TIDX & 63; const int gw = BIDX * 8 + (TIDX >> 6), NGW = GDIM * 8;
    for (int row = gw; row < T; row += NGW) {
        const f32x4* xr = (const f32x4*)(xin + (size_t)row * DM) + lane; float s = 0.f;
        f32x4 v[4];
#pragma unroll
        for (int j = 0; j < 4; ++j) { v[j] = xr[64 * j]; s += (v[j][0] * v[j][0] + v[j][1] * v[j][1]) + (v[j][2] * v[j][2] + v[j][3] * v[j][3]); }
        s = wave_sum(s);
#pragma unroll
        for (int j = 0; j < 4; ++j) { u32x2 w; w.x = cvt_pk(v[j][0], v[j][1]); w.y = cvt_pk(v[j][2], v[j][3]); *(u32x2*)(xb + (size_t)row * XBLD + 4 * lane + 256 * j) = w; }
        if (lane < 16) rss[(size_t)row * 16 + lane] = lane == 0 ? s : 0.f;
    }
}
__device__ __forceinline__ void final_norm(const int TIDX, const int BIDX, const int GDIM, float* out, const float* rss, const float* gfin) {
    const int lane = TIDX & 63; const int gw = BIDX * 8 + (TIDX >> 6), NGW = GDIM * 8;
    for (int row = gw; row < T; row += NGW) {
        const float r = pg8::row_rinv(rss, row);
        f32x4* xr = (f32x4*)(out + (size_t)row * DM) + lane; const f32x4* gp = (const f32x4*)gfin + lane;
#pragma unroll
        for (int j = 0; j < 4; ++j) { f32x4 v = xr[64 * j]; const f32x4 g = gp[64 * j]; v = v * r * g;
            xr[64 * j] = v; }
    }
}

__device__ __forceinline__ void prep_p(const int TIDX, const int BIDX, const int GDIM, const float* pin, bf16_t* xb) {
    const int lane = TIDX & 63; const int gw = BIDX * 8 + (TIDX >> 6), NGW = GDIM * 8;
    for (int row = gw; row < T; row += NGW) { const f32x4 v = ((const f32x4*)(pin + (size_t)row * PLE))[lane];
        u32x2 w; w.x = cvt_pk(v[0], v[1]); w.y = cvt_pk(v[2], v[3]); *(u32x2*)(xb + (size_t)row * XBLD + 1024 + 4 * lane) = w; }
}
__device__ __forceinline__ void prep_qk(const int TIDX, const int BIDX, const int GDIM, bf16_t* Z, const f32x2* cs, const float* gq, const float* gk, int N) {
    const int gthreads = GDIM * 512, gtid = BIDX * 512 + TIDX;
    for (int it = gtid; it < T * 40; it += gthreads) {
        const int a = it & 1, hv = (it >> 1) % 20, row = (it >> 1) / 20;
        const bool isq = hv < 16; const int coloff = isq ? OFF_AQ + hv * 64 : OFF_AK + (hv - 16) * 64;
        bf16_t* p = Z + (size_t)row * INW + coloff + a * 32;
        u32x4 w[4];
#pragma unroll
        for (int j = 0; j < 4; ++j) w[j] = ((const u32x4*)p)[j];
        float x[32];
#pragma unroll
        for (int j = 0; j < 4; ++j) { x[8 * j + 0] = bflo(w[j].x); x[8 * j + 1] = bfhi(w[j].x); x[8 * j + 2] = bflo(w[j].y); x[8 * j + 3] = bfhi(w[j].y);
            x[8 * j + 4] = bflo(w[j].z); x[8 * j + 5] = bfhi(w[j].z); x[8 * j + 6] = bflo(w[j].w); x[8 * j + 7] = bfhi(w[j].w); }
        float ss = 0.f;
#pragma unroll
        for (int d = 0; d < 32; ++d) ss += x[d] * x[d];
        ss += __shfl_xor(ss, 1);
        float r = rsqrtf(ss * (1.f / 64.f) + EPS); if (isq) r *= 0.125f * 1.4426950408889634f;
        const float* g = (isq ? gq : gk) + a * 32;
        const int t = row % N; const int pos = a == 0 ? (t >> 6) : (t & 63);
        const f32x2* c = cs + pos * 16;
        float y[32];
#pragma unroll
        for (int i = 0; i < 16; ++i) { const f32x2 cc = c[i]; const float x1 = x[i] * g[i], x2 = x[16 + i] * g[16 + i];
            y[i] = (x1 * cc.x - x2 * cc.y) * r; y[16 + i] = (x2 * cc.x + x1 * cc.y) * r; }
#pragma unroll
        for (int j = 0; j < 4; ++j) { u32x4 o; o.x = cvt_pk(y[8 * j], y[8 * j + 1]); o.y = cvt_pk(y[8 * j + 2], y[8 * j + 3]); o.z = cvt_pk(y[8 * j + 4], y[8 * j + 5]); o.w = cvt_pk(y[8 * j + 6], y[8 * j + 7]);
            ((u32x4*)p)[j] = o; }
    }
}
__device__ __forceinline__ void prep_vt(const int TIDX, const int BIDX, const int GDIM, const bf16_t* Z, bf16_t* VT, int N, unsigned char* lds) {
    const int tid = TIDX; bf16_t* Ts = (bf16_t*)lds;
    const int nc = N / 64;
    for (int it = BIDX; it < (T / 64) * 4; it += GDIM) {
        const int kvh = it & 3, cgl = it >> 2, seq = cgl / nc, c = cgl % nc;
        { const int t = tid >> 3, ch = tid & 7; const u32x4 v = *(const u32x4*)(Z + (size_t)(cgl * 64 + t) * INW + OFF_AV + kvh * 64 + ch * 8); *(u32x4*)(Ts + t * 72 + ch * 8) = v; }
        __syncthreads();
        { const int d = tid >> 3, ch = tid & 7; unsigned short e[8];
#pragma unroll
            for (int i = 0; i < 8; ++i) e[i] = Ts[(ch * 8 + i) * 72 + d];
            u32x4 o; o.x = e[0] | ((unsigned)e[1] << 16); o.y = e[2] | ((unsigned)e[3] << 16); o.z = e[4] | ((unsigned)e[5] << 16); o.w = e[6] | ((unsigned)e[7] << 16);
            *(u32x4*)(VT + (size_t)((seq * 4 + kvh) * 64 + d) * N + c * 64 + ch * 8) = o; }
        __syncthreads();
    }
}
template <int HALFW> __device__ __forceinline__ void pool_item(const bf16_t* Z, bf16_t* Y, int N, int row, int c8) {
    const int t = row % N;
    float s[8];
#pragma unroll
    for (int e = 0; e < 8; ++e) s[e] = 0.f;
    u32x4 w[2 * HALFW];
#pragma unroll
    for (int k = 0; k < 2 * HALFW; ++k) { const int q = t - HALFW + k; const bool ok = q >= 0 && q < N;
        w[k] = ok ? *(const u32x4*)(Z + (size_t)(row - HALFW + k) * INW + OFF_POOL + c8) : (u32x4){0u, 0u, 0u, 0u}; }
#pragma unroll
    for (int k = 0; k < 2 * HALFW; ++k) { s[0] += bflo(w[k].x); s[1] += bfhi(w[k].x); s[2] += bflo(w[k].y); s[3] += bfhi(w[k].y); s[4] += bflo(w[k].z); s[5] += bfhi(w[k].z); s[6] += bflo(w[k].w); s[7] += bfhi(w[k].w); }
    const int lo = t - HALFW < 0 ? 0 : t - HALFW, hi = t + HALFW > N ? N : t + HALFW;
    const float ic = frcp((float)(hi - lo));
    const u32x4 c = w[HALFW];
    const float u[8] = {bflo(c.x), bfhi(c.x), bflo(c.y), bfhi(c.y), bflo(c.z), bfhi(c.z), bflo(c.w), bfhi(c.w)};
    u32x4 o; o.x = cvt_pk(s[0] * ic - u[0], s[1] * ic - u[1]); o.y = cvt_pk(s[2] * ic - u[2], s[3] * ic - u[3]); o.z = cvt_pk(s[4] * ic - u[4], s[5] * ic - u[5]); o.w = cvt_pk(s[6] * ic - u[6], s[7] * ic - u[7]);
    *(u32x4*)(Y + (size_t)row * YLD + c8) = o;
}
__device__ __forceinline__ void prep_pool(const int TIDX, const int BIDX, const int GDIM, const bf16_t* Z, bf16_t* Y, int N) {
    const int gthreads = GDIM * 512, gtid = BIDX * 512 + TIDX;
    for (int it = gtid; it < T * 64; it += gthreads) {
        const int g = it / (T * 16), rem = it % (T * 16), row = rem >> 4, c8 = g * 128 + (rem & 15) * 8;
        if (g == 0) pool_item<1>(Z, Y, N, row, c8); else if (g == 1) pool_item<2>(Z, Y, N, row, c8); else if (g == 2) pool_item<4>(Z, Y, N, row, c8); else pool_item<8>(Z, Y, N, row, c8);
    }
}

__device__ __forceinline__ void hg_pass1(const int TIDX, const int BIDX, const int GDIM, const bf16_t* Z, bf16_t* ST, float* DEC, const float* LBl  , int N, unsigned char* lds) {
    const int tid = TIDX, lane = tid & 63, wid = tid >> 6, r32 = lane & 31, hi = lane >> 5;
    const int ch = tid & 127, qq = tid >> 7, nc = N / 64;
    bf16_t* Ktf = (bf16_t*)lds;
    bf16_t* Ktb = (bf16_t*)(lds + 18432);
    bf16_t* Vt = (bf16_t*)(lds + 36864);
    float* qtot = (float*)(lds + 55296);
    for (int u = BIDX; u < (T / 64) * 4; u += GDIM) {
        const int h = u & 3, cgl = u >> 2, seq = cgl / nc, c = cgl % nc, r0 = cgl * 64;
        const float lbf = LBl[h * 128 + ch], lbb = LBl[512 + h * 128 + ch];
        const bf16_t* zf = Z + (size_t)(r0 + qq * 16) * INW + OFF_HFF + h * 128 + ch;
        const bf16_t* zb = Z + (size_t)(r0 + qq * 16) * INW + OFF_HFB + h * 128 + ch;
        const bf16_t* zv = Z + (size_t)(r0 + qq * 16) * INW + OFF_HI + h * 128 + ch;
        float kf[16], pf[16], lb_[16], kb[16], pb[16]; unsigned short vv[16];
        float runf = 0.f, runb = 0.f;
#pragma unroll
        for (int i = 0; i < 16; ++i) {
            { const float z = bf2f(zf[(size_t)i * INW]); const float e = __expf(-z), sg = frcp(1.f + e); kf[i] = (1.f - lbf) * e * sg; runf += __logf(lbf + (1.f - lbf) * sg); pf[i] = runf; }
            { const float z = bf2f(zb[(size_t)i * INW]); const float e = __expf(-z), sg = frcp(1.f + e); kb[i] = (1.f - lbb) * e * sg; lb_[i] = __logf(lbb + (1.f - lbb) * sg); runb += lb_[i]; pb[i] = runb; }
            vv[i] = zv[(size_t)i * INW]; }
        qtot[qq * 128 + ch] = runf; qtot[512 + qq * 128 + ch] = runb;
        __syncthreads();
        const float f0 = qtot[ch], f1 = qtot[128 + ch], f2 = qtot[256 + ch], f3 = qtot[384 + ch];
        const float b0 = qtot[512 + ch], b1 = qtot[640 + ch], b2 = qtot[768 + ch], b3 = qtot[896 + ch];
        const float totf = (f0 + f1) + (f2 + f3), totb = (b0 + b1) + (b2 + b3);
        const float beff = (qq > 0 ? f0 : 0.f) + (qq > 1 ? f1 : 0.f) + (qq > 2 ? f2 : 0.f);
        const float befb = (qq > 0 ? b0 : 0.f) + (qq > 1 ? b1 : 0.f) + (qq > 2 ? b2 : 0.f);
        unsigned pkf[8], pkb[8];
#pragma unroll
        for (int i = 0; i < 16; i += 2) {
            pkf[i >> 1] = cvt_pk(kf[i] * __expf(totf - (beff + pf[i])), kf[i + 1] * __expf(totf - (beff + pf[i + 1])));
            pkb[i >> 1] = cvt_pk(kb[i] * __expf(befb + pb[i] - lb_[i]), kb[i + 1] * __expf(befb + pb[i + 1] - lb_[i + 1])); }
        *(u32x4*)(Ktf + ch * 72 + qq * 16) = (u32x4){pkf[0], pkf[1], pkf[2], pkf[3]}; *(u32x4*)(Ktf + ch * 72 + qq * 16 + 8) = (u32x4){pkf[4], pkf[5], pkf[6], pkf[7]};
        *(u32x4*)(Ktb + ch * 72 + qq * 16) = (u32x4){pkb[0], pkb[1], pkb[2], pkb[3]}; *(u32x4*)(Ktb + ch * 72 + qq * 16 + 8) = (u32x4){pkb[4], pkb[5], pkb[6], pkb[7]};
        *(u32x4*)(Vt + ch * 72 + qq * 16) = (u32x4){vv[0] | ((unsigned)vv[1] << 16), vv[2] | ((unsigned)vv[3] << 16), vv[4] | ((unsigned)vv[5] << 16), vv[6] | ((unsigned)vv[7] << 16)};
        *(u32x4*)(Vt + ch * 72 + qq * 16 + 8) = (u32x4){vv[8] | ((unsigned)vv[9] << 16), vv[10] | ((unsigned)vv[11] << 16), vv[12] | ((unsigned)vv[13] << 16), vv[14] | ((unsigned)vv[15] << 16)};
        const int sidxf = ((seq * 4 + h) * 2 + 0) * nc + c, sidxb = ((seq * 4 + h) * 2 + 1) * nc + c;
        if (tid < 128) { DEC[(size_t)sidxf * 128 + tid] = __expf(totf); DEC[(size_t)sidxb * 128 + tid] = __expf(totb); }
        __syncthreads();
        const int ti = wid >> 1;
#pragma unroll
        for (int dir = 0; dir < 2; ++dir) { const bf16_t* Kt = dir ? Ktb : Ktf; bf16_t* Sb = ST + (size_t)(dir ? sidxb : sidxf) * 16384;
#pragma unroll
            for (int jj = 0; jj < 2; ++jj) { const int tj = 2 * (wid & 1) + jj; f32x16 acc = {};
#pragma unroll
                for (int s = 0; s < 4; ++s) { const bf16x8 X = *(const bf16x8*)(Kt + (32 * ti + r32) * 72 + 16 * s + 8 * hi); const bf16x8 Y = *(const bf16x8*)(Vt + (32 * tj + r32) * 72 + 16 * s + 8 * hi); acc = mfma32(X, Y, acc); }
#pragma unroll
                for (int rg = 0; rg < 4; ++rg) { u32x2 w; w.x = cvt_pk(acc[4 * rg], acc[4 * rg + 1]); w.y = cvt_pk(acc[4 * rg + 2], acc[4 * rg + 3]);
                    *(u32x2*)(Sb + (32 * tj + r32) * 128 + 32 * ti + 8 * rg + 4 * hi) = w; } } }
        __syncthreads();
    }
}
__device__ __forceinline__ void hg_scan(const int TIDX, const int BIDX, const int GDIM, bf16_t* ST, const float* DEC, int N) {
    const int nc = N / 64, nchains = (T / N) * 8; const int total = nchains * 8192;
    for (int idx = BIDX * 512 + TIDX; idx < total; idx += GDIM * 512) {
        const int chain = idx >> 13, e2 = idx & 8191, dir = chain & 1, cho = (e2 * 2) & 127;
        float s0 = 0.f, s1 = 0.f;
        for (int st = 0; st < nc; st += 8) {
            unsigned uu[8]; f32x2 dd[8];
#pragma unroll
            for (int k = 0; k < 8; ++k) { const int c = dir ? nc - 1 - (st + k) : st + k; const size_t si = (size_t)chain * nc + c;
                uu[k] = *(const unsigned*)(ST + si * 16384 + e2 * 2); dd[k] = *(const f32x2*)(DEC + si * 128 + cho); }
#pragma unroll
            for (int k = 0; k < 8; ++k) { const int c = dir ? nc - 1 - (st + k) : st + k; const size_t si = (size_t)chain * nc + c;
                *(unsigned*)(ST + si * 16384 + e2 * 2) = cvt_pk(s0, s1);
                s0 = dd[k][0] * s0 + bflo(uu[k]); s1 = dd[k][1] * s1 + bfhi(uu[k]); }
        }
    }
}
__device__ __forceinline__ void hg_pass3(const int TIDX, const int BIDX, const int GDIM, const bf16_t* Z, const bf16_t* ST, bf16_t* Y, const float* LBl, const float* onorm, int N, unsigned char* lds) {
    const int tid = TIDX, lane = tid & 63, wid = tid >> 6, r32 = lane & 31, hi = lane >> 5;
    const int ch = tid & 127, qq = tid >> 7, nc = N / 64;
    bf16_t* Qt = (bf16_t*)lds;
    bf16_t* Kt = (bf16_t*)(lds + 17408);
    bf16_t* Qh = (bf16_t*)(lds + 34816);
    bf16_t* Vt = (bf16_t*)(lds + 52224);
    float* qtot = (float*)(lds + 70656);
    float* ssq = (float*)(lds + 72704);
    const int dt = wid >> 1, jt = wid & 1;
    for (int u = BIDX; u < (T / 64) * 4; u += GDIM) {
        const int h = u & 3, cgl = u >> 2, seq = cgl / nc, c = cgl % nc, r0 = cgl * 64;
        f32x16 o = {};
        { const bf16_t* zv = Z + (size_t)(r0 + qq * 16) * INW + OFF_HI + h * 128 + ch; unsigned short vv[16];
#pragma unroll
            for (int i = 0; i < 16; ++i) vv[i] = zv[(size_t)i * INW];
            *(u32x4*)(Vt + ch * 72 + qq * 16) = (u32x4){vv[0] | ((unsigned)vv[1] << 16), vv[2] | ((unsigned)vv[3] << 16), vv[4] | ((unsigned)vv[5] << 16), vv[6] | ((unsigned)vv[7] << 16)};
            *(u32x4*)(Vt + ch * 72 + qq * 16 + 8) = (u32x4){vv[8] | ((unsigned)vv[9] << 16), vv[10] | ((unsigned)vv[11] << 16), vv[12] | ((unsigned)vv[13] << 16), vv[14] | ((unsigned)vv[15] << 16)}; }
#pragma unroll 1
        for (int dir = 0; dir < 2; ++dir) {
            const float lb = LBl[dir * 512 + h * 128 + ch];
            const bf16_t* zf = Z + (size_t)(r0 + qq * 16) * INW + (dir ? OFF_HFB : OFF_HFF) + h * 128 + ch;
            const bf16_t* zq = Z + (size_t)(r0 + qq * 16) * INW + OFF_HQ + h * 128 + ch;
            float lf[16], kk[16], pre[16], qv[16]; float run = 0.f;
#pragma unroll
            for (int i = 0; i < 16; ++i) { const float z = bf2f(zf[(size_t)i * INW]); const float e = __expf(-z), sg = frcp(1.f + e);
                lf[i] = __logf(lb + (1.f - lb) * sg); kk[i] = (1.f - lb) * e * sg; run += lf[i]; pre[i] = run; qv[i] = bf2f(zq[(size_t)i * INW]); }
            qtot[qq * 128 + ch] = run;
            __syncthreads();
            const float t0 = qtot[ch], t1 = qtot[128 + ch], t2 = qtot[256 + ch], t3 = qtot[384 + ch];
            const float before = (qq > 0 ? t0 : 0.f) + (qq > 1 ? t1 : 0.f) + (qq > 2 ? t2 : 0.f);
            const float after = (qq < 1 ? t1 : 0.f) + (qq < 2 ? t2 : 0.f) + (qq < 3 ? t3 : 0.f);
            const float ref = dir == 0 ? (t0 + t1) : (t2 + t3);
#pragma unroll
            for (int i = 0; i < 16; ++i) {
                const float cum = dir == 0 ? before + pre[i] : after + (run - pre[i] + lf[i]);
                const float d = cum - ref; const int p = qq * 16 + i;
                Qt[p * 136 + ch] = f2bf(qv[i] * __expf(d)); Kt[p * 136 + ch] = f2bf(kk[i] * __expf(-d)); Qh[p * 136 + ch] = f2bf(qv[i] * __expf(cum)); }
            __syncthreads();
            f32x16 a0 = {}, a1 = {};
#pragma unroll
            for (int s = 0; s < 8; ++s) { const bf16x8 Yq = *(const bf16x8*)(Qt + (32 * jt + r32) * 136 + 16 * s + 8 * hi);
                const bf16x8 X0 = *(const bf16x8*)(Kt + r32 * 136 + 16 * s + 8 * hi); const bf16x8 X1 = *(const bf16x8*)(Kt + (32 + r32) * 136 + 16 * s + 8 * hi);
                a0 = mfma32(X0, Yq, a0); a1 = mfma32(X1, Yq, a1); }
            const int j = 32 * jt + r32;
#pragma unroll
            for (int r = 0; r < 16; ++r) { const int l0 = crow(r, hi), l1 = 32 + l0;
                const bool k0 = dir == 0 ? (l0 <= j) : (l0 >= j), k1 = dir == 0 ? (l1 <= j) : (l1 >= j);
                a0[r] = k0 ? a0[r] : 0.f; a1[r] = k1 ? a1[r] : 0.f; }
            bf16x8 pa[2][2];
#pragma unroll
            for (int u2 = 0; u2 < 2; ++u2) { u32x4 w0, w1;
                w0.x = cvt_pk(a0[8 * u2], a0[8 * u2 + 1]); w0.y = cvt_pk(a0[8 * u2 + 2], a0[8 * u2 + 3]); w0.z = cvt_pk(a0[8 * u2 + 4], a0[8 * u2 + 5]); w0.w = cvt_pk(a0[8 * u2 + 6], a0[8 * u2 + 7]);
                w1.x = cvt_pk(a1[8 * u2], a1[8 * u2 + 1]); w1.y = cvt_pk(a1[8 * u2 + 2], a1[8 * u2 + 3]); w1.z = cvt_pk(a1[8 * u2 + 4], a1[8 * u2 + 5]); w1.w = cvt_pk(a1[8 * u2 + 6], a1[8 * u2 + 7]);
                pa[0][u2] = __builtin_bit_cast(bf16x8, w0); pa[1][u2] = __builtin_bit_cast(bf16x8, w1); }
#pragma unroll
            for (int lt = 0; lt < 2; ++lt)
#pragma unroll
                for (int u2 = 0; u2 < 2; ++u2) { const int base = 32 * lt + 16 * u2;
                    const s16x4 vlo = *(const s16x4*)(Vt + (32 * dt + r32) * 72 + base + 4 * hi); const s16x4 vhi = *(const s16x4*)(Vt + (32 * dt + r32) * 72 + base + 8 + 4 * hi);
                    const bf16x8 X = (bf16x8){vlo[0], vlo[1], vlo[2], vlo[3], vhi[0], vhi[1], vhi[2], vhi[3]};
                    o = mfma32(X, pa[lt][u2], o); }
            const int sidx = ((seq * 4 + h) * 2 + dir) * nc + c;
            const bf16_t* Sb = ST + (size_t)sidx * 16384 + (32 * dt + r32) * 128 + 8 * hi;
#pragma unroll
            for (int s = 0; s < 8; ++s) { const bf16x8 X = *(const bf16x8*)(Sb + 16 * s); const bf16x8 Yq = *(const bf16x8*)(Qh + (32 * jt + r32) * 136 + 16 * s + 8 * hi); o = mfma32(X, Yq, o); }
            __syncthreads();
        }
        float ss = 0.f;
#pragma unroll
        for (int r = 0; r < 16; ++r) ss += o[r] * o[r];
        ss += __shfl_xor(ss, 32);
        if (hi == 0) ssq[dt * 64 + 32 * jt + r32] = ss;
        __syncthreads();
        const int j = 32 * jt + r32;
        const float rinv = rsqrtf(((ssq[j] + ssq[64 + j]) + (ssq[128 + j] + ssq[192 + j])) * (1.f / 128.f) + EPS);
#pragma unroll
        for (int rg = 0; rg < 4; ++rg) { const int dv = 32 * dt + 8 * rg + 4 * hi;
            const u32x2 gw = *(const u32x2*)(Z + (size_t)(r0 + j) * INW + OFF_HG + h * 128 + dv); const f32x4 gn = *(const f32x4*)(onorm + dv);
            const float g0 = bflo(gw.x), g1 = bfhi(gw.x), g2 = bflo(gw.y), g3 = bfhi(gw.y);
            const float y0 = o[4 * rg] * rinv * gn[0] * g0 * sigm(g0), y1 = o[4 * rg + 1] * rinv * gn[1] * g1 * sigm(g1), y2 = o[4 * rg + 2] * rinv * gn[2] * g2 * sigm(g2), y3 = o[4 * rg + 3] * rinv * gn[3] * g3 * sigm(g3);
            u32x2 w; w.x = cvt_pk(y0, y1); w.y = cvt_pk(y2, y3);
            *(u32x2*)(Y + (size_t)(r0 + j) * YLD + 512 + h * 128 + dv) = w; }
        __syncthreads();
    }
}

#define ATT_PACK(P0, P1, PA) do { _Pragma("unroll") for (int u2 = 0; u2 < 2; ++u2) { u32x4 w0, w1; \
    w0.x = cvt_pk(P0[8 * u2], P0[8 * u2 + 1]); w0.y = cvt_pk(P0[8 * u2 + 2], P0[8 * u2 + 3]); w0.z = cvt_pk(P0[8 * u2 + 4], P0[8 * u2 + 5]); w0.w = cvt_pk(P0[8 * u2 + 6], P0[8 * u2 + 7]); \
    w1.x = cvt_pk(P1[8 * u2], P1[8 * u2 + 1]); w1.y = cvt_pk(P1[8 * u2 + 2], P1[8 * u2 + 3]); w1.z = cvt_pk(P1[8 * u2 + 4], P1[8 * u2 + 5]); w1.w = cvt_pk(P1[8 * u2 + 6], P1[8 * u2 + 7]); \
    PA[0][u2] = __builtin_bit_cast(bf16x8, w0); PA[1][u2] = __builtin_bit_cast(bf16x8, w1); } } while (0)
#define ATT_SOFTMAX(P0, P1, LR) do { \
    float ps = 0.f; _Pragma("unroll") for (int r = 0; r < 16; ++r) { P0[r] = __builtin_amdgcn_exp2f(P0[r]); P1[r] = __builtin_amdgcn_exp2f(P1[r]); ps += P0[r] + P1[r]; } \
    LR += ps; } while (0)
__device__ __forceinline__ void attn_phase(const int TIDX, const int BIDX, const int GDIM, const bf16_t* Z, const bf16_t* VT, bf16_t* Y, const float* gq, const float* gk, int N, unsigned char* lds) {
    const int tid = TIDX, lane = tid & 63, wid = tid >> 6, r32 = lane & 31, hi = lane >> 5;
    const int nq = N / 128, NT = N / 64;
    const int srow = tid >> 3, sch = tid & 7;
    float negshift;
    { float a = fabsf(gq[lane]), b = fabsf(gk[lane]);
#pragma unroll
      for (int o = 1; o < 64; o <<= 1) { a = fmaxf(a, __shfl_xor(a, o)); b = fmaxf(b, __shfl_xor(b, o)); }
      negshift = __uint_as_float(__builtin_amdgcn_readfirstlane(__float_as_uint(-fmaxf(11.5416f * a * b * 1.02f - 24.0f, 0.f)))); }
    const int vcu = (GDIM % 8 == 0) ? (BIDX % 8) * (GDIM / 8) + BIDX / 8 : BIDX;
    const int NU = (T / 128) * 4, upc = (NU + GDIM - 1) / GDIM;
    for (int ui = 0; ui < upc; ++ui) {
        const int u = vcu * upc + ui; if (u >= NU) break;
        const int qblk = u % nq, sk = u / nq, kvh = sk & 3, seq = sk >> 2;
        const int seqrow0 = seq * N;
        const int head = kvh * 4 + (wid >> 1); const int qrowA = seqrow0 + qblk * 128 + 64 * (wid & 1) + r32, qrowB = qrowA + 32;
        bf16x8 qa[4], qb[4];
        { const bf16_t* qp = Z + (size_t)qrowA * INW + OFF_AQ + head * 64 + hi * 8;
#pragma unroll
            for (int d0 = 0; d0 < 4; ++d0) { qa[d0] = *(const bf16x8*)(qp + d0 * 16); qb[d0] = *(const bf16x8*)(qp + (size_t)32 * INW + d0 * 16); } }
        const bf16_t* kg = Z + (size_t)(seqrow0 + srow) * INW + OFF_AK + kvh * 64 + sch * 8;
        const bf16_t* vg = VT + (size_t)((seq * 4 + kvh) * 64 + srow) * N + sch * 8;
        u32x4 kreg = *(const u32x4*)kg, vreg = *(const u32x4*)vg;
        *(u32x4*)(lds + srow * 144 + sch * 16) = kreg; *(u32x4*)(lds + 18432 + srow * 144 + sch * 16) = vreg;
        __syncthreads();
        float lA = 0.f, lB = 0.f; f32x16 oA0 = {}, oA1 = {}, oB0 = {}, oB1 = {};
        for (int t = 0; t < NT; ++t) {
            const int buf = t & 1;
            if (t + 1 < NT) { kreg = *(const u32x4*)(kg + (size_t)(t + 1) * 64 * INW); vreg = *(const u32x4*)(vg + (size_t)(t + 1) * 64); }
            const unsigned char* Ks = lds + buf * 9216; const unsigned char* Vs = lds + 18432 + buf * 9216;
            f32x16 pA0 = {}, pA1 = {}, pB0 = {}, pB1 = {};
#pragma unroll
            for (int d0 = 0; d0 < 4; ++d0) { const bf16x8 k0 = *(const bf16x8*)(Ks + r32 * 144 + (d0 * 16 + hi * 8) * 2); const bf16x8 k1 = *(const bf16x8*)(Ks + (32 + r32) * 144 + (d0 * 16 + hi * 8) * 2);
                pA0 = mfma32(k0, qa[d0], pA0); pA1 = mfma32(k1, qa[d0], pA1); pB0 = mfma32(k0, qb[d0], pB0); pB1 = mfma32(k1, qb[d0], pB1); }
            bf16x8 paA[2][2], paB[2][2];
            if (negshift != 0.f) {
#pragma unroll
                for (int r = 0; r < 16; ++r) { pA0[r] += negshift; pA1[r] += negshift; pB0[r] += negshift; pB1[r] += negshift; } }
            ATT_SOFTMAX(pA0, pA1, lA); ATT_PACK(pA0, pA1, paA);
            ATT_SOFTMAX(pB0, pB1, lB); ATT_PACK(pB0, pB1, paB);
#pragma unroll
            for (int hh = 0; hh < 2; ++hh)
#pragma unroll
                for (int u2 = 0; u2 < 2; ++u2) { const int base = 32 * hh + 16 * u2;
                    { const s16x4 vlo = *(const s16x4*)(Vs + r32 * 144 + (base + 4 * hi) * 2); const s16x4 vhi = *(const s16x4*)(Vs + r32 * 144 + (base + 8 + 4 * hi) * 2);
                      const bf16x8 vf = (bf16x8){vlo[0], vlo[1], vlo[2], vlo[3], vhi[0], vhi[1], vhi[2], vhi[3]};
                      oA0 = mfma32(vf, paA[hh][u2], oA0); oB0 = mfma32(vf, paB[hh][u2], oB0); }
                    { const s16x4 vlo = *(const s16x4*)(Vs + (32 + r32) * 144 + (base + 4 * hi) * 2); const s16x4 vhi = *(const s16x4*)(Vs + (32 + r32) * 144 + (base + 8 + 4 * hi) * 2);
                      const bf16x8 vf = (bf16x8){vlo[0], vlo[1], vlo[2], vlo[3], vhi[0], vhi[1], vhi[2], vhi[3]};
                      oA1 = mfma32(vf, paA[hh][u2], oA1); oB1 = mfma32(vf, paB[hh][u2], oB1); } }
            if (t + 1 < NT) { *(u32x4*)(lds + (buf ^ 1) * 9216 + srow * 144 + sch * 16) = kreg; *(u32x4*)(lds + 18432 + (buf ^ 1) * 9216 + srow * 144 + sch * 16) = vreg; }
            __syncthreads();
        }
        lA += __shfl_xor(lA, 32); lB += __shfl_xor(lB, 32);
        const float invA = 1.f / lA, invB = 1.f / lB;
        bf16_t* ypA = Y + (size_t)qrowA * YLD + 1024 + head * 64; bf16_t* ypB = ypA + (size_t)32 * YLD;
#pragma unroll
        for (int rg = 0; rg < 4; ++rg) { const int d = 8 * rg + 4 * hi; u32x2 w;
            w.x = cvt_pk(oA0[4 * rg] * invA, oA0[4 * rg + 1] * invA); w.y = cvt_pk(oA0[4 * rg + 2] * invA, oA0[4 * rg + 3] * invA); *(u32x2*)(ypA + d) = w;
            w.x = cvt_pk(oA1[4 * rg] * invA, oA1[4 * rg + 1] * invA); w.y = cvt_pk(oA1[4 * rg + 2] * invA, oA1[4 * rg + 3] * invA); *(u32x2*)(ypA + 32 + d) = w;
            w.x = cvt_pk(oB0[4 * rg] * invB, oB0[4 * rg + 1] * invB); w.y = cvt_pk(oB0[4 * rg + 2] * invB, oB0[4 * rg + 3] * invB); *(u32x2*)(ypB + d) = w;
            w.x = cvt_pk(oB1[4 * rg] * invB, oB1[4 * rg + 1] * invB); w.y = cvt_pk(oB1[4 * rg + 2] * invB, oB1[4 * rg + 3] * invB); *(u32x2*)(ypB + 32 + d) = w; }
    }
}

__device__ __forceinline__ float gelu_tanh(float a) { const float e = __builtin_amdgcn_exp2f(a * (2.3022081984f + 0.1029432396f * (a * a))); return a - a * frcp(e + 1.f);   }
__device__ __forceinline__ void unpack8(const u32x4 w, float* x) { x[0] = bflo(w.x); x[1] = bfhi(w.x); x[2] = bflo(w.y); x[3] = bfhi(w.y); x[4] = bflo(w.z); x[5] = bfhi(w.z); x[6] = bflo(w.w); x[7] = bfhi(w.w); }
__device__ __forceinline__ void conv_act(const int TIDX, const int BIDX, const int GDIM, const bf16_t* U, bf16_t* ACT, const float* cw, const float* cb, int N) {
    const int gthreads = GDIM * 512, gtid = BIDX * 512 + TIDX;
    constexpr int NCG = DFF / 8;
    for (int it = gtid; it < (T / 16) * NCG; it += gthreads) {
        const int cg8 = it % NCG, run = it / NCG, row0 = run * 16, t0 = row0 % N, c0 = cg8 * 8;
        float wa[3][8], wg[3][8], ba[8], bg[8];
#pragma unroll
        for (int k = 0; k < 3; ++k)
#pragma unroll
            for (int e = 0; e < 8; ++e) { wa[k][e] = cw[k * DFF2 + c0 + e]; wg[k][e] = cw[k * DFF2 + DFF + c0 + e]; }
#pragma unroll
        for (int e = 0; e < 8; ++e) { ba[e] = cb[c0 + e]; bg[e] = cb[DFF + c0 + e]; }
        float pa[8], pg[8], ca[8], cgv[8], na[8], ng[8];
        const u32x4 zero = (u32x4){0u, 0u, 0u, 0u};
        { const u32x4 a = t0 > 0 ? *(const u32x4*)(U + (size_t)(row0 - 1) * DFF2 + c0) : zero; const u32x4 g = t0 > 0 ? *(const u32x4*)(U + (size_t)(row0 - 1) * DFF2 + DFF + c0) : zero; unpack8(a, pa); unpack8(g, pg); }
        { const u32x4 a = *(const u32x4*)(U + (size_t)row0 * DFF2 + c0); const u32x4 g = *(const u32x4*)(U + (size_t)row0 * DFF2 + DFF + c0); unpack8(a, ca); unpack8(g, cgv); }
#pragma unroll 4
        for (int i = 0; i < 16; ++i) { const int row = row0 + i; const bool hasn = (t0 + i + 1) < N;
            const u32x4 a = hasn ? *(const u32x4*)(U + (size_t)(row + 1) * DFF2 + c0) : zero; const u32x4 g = hasn ? *(const u32x4*)(U + (size_t)(row + 1) * DFF2 + DFF + c0) : zero; unpack8(a, na); unpack8(g, ng);
            float r[8];
#pragma unroll
            for (int e = 0; e < 8; ++e) { const float av = pa[e] * wa[0][e] + ca[e] * wa[1][e] + na[e] * wa[2][e] + ba[e]; const float gv = pg[e] * wg[0][e] + cgv[e] * wg[1][e] + ng[e] * wg[2][e] + bg[e]; r[e] = gelu_tanh(av) * gv; }
            u32x4 o; o.x = cvt_pk(r[0], r[1]); o.y = cvt_pk(r[2], r[3]); o.z = cvt_pk(r[4], r[5]); o.w = cvt_pk(r[6], r[7]);
            *(u32x4*)(ACT + (size_t)row * DFF + c0) = o;
#pragma unroll
            for (int e = 0; e < 8; ++e) { pa[e] = ca[e]; pg[e] = cgv[e]; ca[e] = na[e]; cgv[e] = ng[e]; } }
    }
}


constexpr size_t WS_BAR = 256 * 1024;
#define XB_TMO      128
#define XB_XCNT(j)  (256  + 64 * (j))
#define XB_XSUB(j)  (1280 + 64 * (j))
#define XB_XGEN(j)  (2304 + 64 * (j))
#define XB_TOP      3328
#define XB_TOPGEN   3392
#define XCD_BAR_WORDS 3456
#define XB_SPIN_CAP (1u << 22)
__device__ __forceinline__ unsigned xb_ld(unsigned* p)              { return __hip_atomic_load(p, __ATOMIC_RELAXED, __HIP_MEMORY_SCOPE_AGENT); }
__device__ __forceinline__ unsigned xb_add(unsigned* p, unsigned v) { return __hip_atomic_fetch_add(p, v, __ATOMIC_RELAXED, __HIP_MEMORY_SCOPE_AGENT); }
__device__ __forceinline__ unsigned xb_xcc_id() { return (unsigned)__builtin_amdgcn_s_getreg((3 << 11) | 20) & 0xFu; }
#define XB_SPIN(cond, bar) do { unsigned _sp = 0; while (cond) { __builtin_amdgcn_s_sleep(1); \
    if ((++_sp & 255u) == 0u) { if (xb_ld(&(bar)[XB_TMO])) break; if (_sp > XB_SPIN_CAP) { atomicAdd(&(bar)[XB_TMO], 1u); break; } } } } while (0)
struct XcdBarrier { unsigned* bar; unsigned x; volatile LAS unsigned* st; };
__device__ __forceinline__ XcdBarrier xcd_barrier_post(unsigned* bar, volatile LAS unsigned* st) {
    XcdBarrier b; b.bar = bar; b.x = xb_xcc_id(); b.st = st;
    if (threadIdx.x == 0) (void)xb_add(&bar[XB_XCNT(b.x)], 1u);
    return b;
}
__device__ __forceinline__ void xcd_barrier_complete(unsigned* bar, unsigned x, unsigned& nloc, unsigned& nx) {
    const unsigned G = gridDim.x * gridDim.y * gridDim.z;
    unsigned sum, cnt, mine, sp = 0u;
    for (;;) {
        sum = 0u; cnt = 0u; mine = 0u;
#pragma unroll
        for (unsigned j = 0; j < 16; ++j) { const unsigned c = xb_ld(&bar[XB_XCNT(j)]); sum += c; cnt += (c > 0u) ? 1u : 0u; mine = (j == x) ? c : mine; }
        if (sum == G) break;
        __builtin_amdgcn_s_sleep(1);
        if ((++sp & 255u) == 0u) { if (xb_ld(&bar[XB_TMO])) break; if (sp > XB_SPIN_CAP) { atomicAdd(&bar[XB_TMO], 1u); break; } }
    }
    nloc = mine > 0u ? mine : 1u; nx = cnt > 0u ? cnt : 1u;
}
__device__ __forceinline__ void xcd_barrier(const XcdBarrier& b) {
    asm volatile("s_waitcnt vmcnt(0)" ::: "memory");
    __syncthreads();
    if (threadIdx.x == 0) {
        unsigned* bar = b.bar;
        __builtin_amdgcn_s_waitcnt(0);
        unsigned nloc = b.st[0], nx = b.st[1];
        if (nloc == 0u) { xcd_barrier_complete(bar, b.x, nloc, nx); b.st[0] = nloc; b.st[1] = nx; }
        const unsigned old = xb_add(&bar[XB_XSUB(b.x)], 1u);
        const unsigned gen = old / nloc;
        if (old + 1u == (gen + 1u) * nloc) {
            __builtin_amdgcn_fence(__ATOMIC_RELEASE, "agent");
            asm volatile("s_waitcnt vmcnt(0)" ::: "memory");
            const unsigned og = xb_add(&bar[XB_TOP], 1u);
            const unsigned tg = og / nx;
            if (og + 1u == (tg + 1u) * nx) xb_add(&bar[XB_TOPGEN], 1u);
            else XB_SPIN(xb_ld(&bar[XB_TOPGEN]) == tg, bar);
            __builtin_amdgcn_fence(__ATOMIC_ACQUIRE, "agent");
            xb_add(&bar[XB_XGEN(b.x)], 1u);
            asm volatile("s_waitcnt vmcnt(0)" ::: "memory");
        } else {
            XB_SPIN(xb_ld(&bar[XB_XGEN(b.x)]) == gen, bar);
            __builtin_amdgcn_fence(__ATOMIC_ACQUIRE, "agent");
            asm volatile("s_waitcnt vmcnt(0)" ::: "memory");
        }
    }
    __syncthreads();
}

__device__ __forceinline__ void conv_fix(const int TIDX, const int BIDX, const int GDIM, const bf16_t* EB, bf16_t* ACT, const float* cw, const float* cb, int N) {
    const int gthreads = GDIM * 512, gtid = BIDX * 512 + TIDX;
    constexpr int NCG = DFF / 8;
    for (int it = gtid; it < (T / 64) * 2 * NCG; it += gthreads) {
        const int cg8 = it % NCG, be = it / NCG, edge = be & 1, blk = be >> 1, c0 = cg8 * 8;
        const int row = blk * 64 + (edge ? 63 : 0), t = row % N;
        const bf16_t* pP = edge ? EB + ((size_t)blk * 4 + 2) * DFF2 : EB + ((size_t)(blk - 1) * 4 + 3) * DFF2;
        const bf16_t* pC = EB + ((size_t)blk * 4 + (edge ? 3 : 0)) * DFF2;
        const bf16_t* pN = edge ? EB + ((size_t)(blk + 1) * 4 + 0) * DFF2 : EB + ((size_t)blk * 4 + 1) * DFF2;
        const bool hasp = t > 0, hasn = t + 1 < N;
        const u32x4 zero = (u32x4){0u, 0u, 0u, 0u};
        float pa[8], pg[8], ca[8], cg[8], na[8], ng[8];
        unpack8(hasp ? *(const u32x4*)(pP + c0) : zero, pa); unpack8(hasp ? *(const u32x4*)(pP + DFF + c0) : zero, pg);
        unpack8(*(const u32x4*)(pC + c0), ca); unpack8(*(const u32x4*)(pC + DFF + c0), cg);
        unpack8(hasn ? *(const u32x4*)(pN + c0) : zero, na); unpack8(hasn ? *(const u32x4*)(pN + DFF + c0) : zero, ng);
        float r[8];
#pragma unroll
        for (int e = 0; e < 8; ++e) { const float av = pa[e] * cw[c0 + e] + ca[e] * cw[DFF2 + c0 + e] + na[e] * cw[2 * DFF2 + c0 + e] + cb[c0 + e];
            const float gv = pg[e] * cw[DFF + c0 + e] + cg[e] * cw[DFF2 + DFF + c0 + e] + ng[e] * cw[2 * DFF2 + DFF + c0 + e] + cb[DFF + c0 + e]; r[e] = gelu_tanh(av) * gv; }
        u32x4 o; o.x = cvt_pk(r[0], r[1]); o.y = cvt_pk(r[2], r[3]); o.z = cvt_pk(r[4], r[5]); o.w = cvt_pk(r[6], r[7]);
        *(u32x4*)(ACT + (size_t)row * DFF + c0) = o;
    }
}

constexpr int STEPS_PER_GROUP = 42, NSTEPS = 1 + NGROUP * STEPS_PER_GROUP;

__global__ void __launch_bounds__(512, 2) mega(Params P) {
    extern __shared__ __attribute__((aligned(16))) unsigned char lds[];
    LAS unsigned char* lds3 = (LAS unsigned char*)lds;
    typedef __attribute__((address_space(4))) const unsigned char* kaptr_t;
    const kaptr_t ka = (kaptr_t)__builtin_amdgcn_kernarg_segment_ptr();
#define KIN(i) (*(const float* const volatile __attribute__((address_space(4)))*)(ka + 8 * (i)))
#define KOUT (*(float* const volatile __attribute__((address_space(4)))*)(ka + 8 * 26))
#define KWS (*(unsigned char* const volatile __attribute__((address_space(4)))*)(ka + 8 * 27))
#define KLO (*(const volatile int __attribute__((address_space(4)))*)(ka + 8 * 28))
#define KHI (*(const volatile int __attribute__((address_space(4)))*)(ka + 8 * 28 + 4))
    const int step_hi = KHI;
    volatile LAS unsigned* MISC = (volatile LAS unsigned*)(lds3 + 131072 + 320);
    if (threadIdx.x < 32) MISC[threadIdx.x] = 0u;
    __syncthreads();
    XcdBarrier gbar = xcd_barrier_post((unsigned*)(KWS + WS_BAR), MISC + 8);
    bool first_sync = true;
    for (int step = KLO; step < step_hi; ++step) {
        unsigned char* ws = KWS;
        int tid_o = threadIdx.x, bx_o = blockIdx.x, G_o = gridDim.x;
        asm volatile("" : "+v"(tid_o)); asm volatile("" : "+s"(bx_o)); asm volatile("" : "+s"(G_o));
        const int G = G_o, bx = bx_o;
        if (step == 0) { phase0(tid_o, bx_o, G_o, ka, lds); }
        else {
            const int g = (step - 1) / STEPS_PER_GROUP, s = (step - 1) % STEPS_PER_GROUP;
            const int N = g == 0 ? 4096 : 8192;
            const float* xin = g == 0 ? KIN(0) : KIN(1) + (size_t)(g - 1) * T * DM;
            float* xout = KOUT + (size_t)g * T * DM;
            bf16_t* XB0 = (bf16_t*)(ws + WS_XB0); bf16_t* XB1 = (bf16_t*)(ws + WS_XB1);
            float* RSS0 = (float*)(ws + WS_RSS); float* RSS1 = RSS0 + (size_t)T * 16;
            bf16_t* Z = (bf16_t*)(ws + WS_Z); bf16_t* YC = (bf16_t*)(ws + WS_YCAT); bf16_t* MG = (bf16_t*)(ws + WS_MERGED);
            bf16_t* ST = (bf16_t*)(ws + WS_ST); bf16_t* FACC = (bf16_t*)(ws + WS_ST); bf16_t* VT = (bf16_t*)(ws + WS_VT); float* DEC = (float*)(ws + WS_DEC);
            bf16_t* ACT = YC; bf16_t* EB = (bf16_t*)(ws + WS_ST + 32 * MiB);
            if (s == 0) group_init(tid_o, bx_o, G_o, xin, XB0, RSS0);
            else if (s == 41) final_norm(tid_o, bx_o, G_o, xout, RSS0, KIN(25));
            else {
                const int layer = (s - 1) / 10, ls = (s - 1) % 10, cur = layer & 1;
                bf16_t* XBc = cur ? XB1 : XB0; bf16_t* XBn = cur ? XB0 : XB1;
                float* RSSc = cur ? RSS1 : RSS0; float* RSSn = cur ? RSS0 : RSS1;
                const float* LBl = (const float*)(ws + WS_LB) + layer * 1024;
                const float* xbase = layer == 0 ? xin : xout;
                if (ls == 0) {
                    pg8::Gemm gm{XBc, (const bf16_t*)(ws + WS_WIN) + (size_t)layer * INW * DM, XBLD, DM};
                    pg8::Sched<INW, 1, 0, 16, 0, 0, 0, 0> S{G, bx};
                    pg8::EpiScale E{Z, INW, RSSc, OFF_GATE / 256};
                    pg8::gemm_phase(tid_o, bx_o, G_o, lds3, gm, S, E);
                } else if (ls == 1) {
                    const float* pin = (g == 0 ? KIN(2) + (size_t)layer * 16384 * PLE : KIN(3) + (size_t)layer * 32768 * PLE + (size_t)(g - 1) * T * PLE);
                    prep_p(tid_o, bx_o, G_o, pin, XBc);
                    prep_qk(tid_o, bx_o, G_o, Z, (const f32x2*)(ws + WS_CS), KIN(11) + layer * 64, KIN(12) + layer * 64, N);
                    prep_vt(tid_o, bx_o, G_o, Z, VT, N, lds);
                    prep_pool(tid_o, bx_o, G_o, Z, YC, N);
                    hg_pass1(tid_o, bx_o, G_o, Z, ST, DEC, LBl, N, lds);
                } else if (ls == 2) {
                    hg_scan(tid_o, bx_o, G_o, ST, DEC, N);
                } else if (ls == 3) {
                    hg_pass3(tid_o, bx_o, G_o, Z, ST, YC, LBl, KIN(10) + layer * 128, N, lds);
                    attn_phase(tid_o, bx_o, G_o, Z, VT, YC, KIN(11) + layer * 64, KIN(12) + layer * 64, N, lds);
                } else if (ls == 4) {
                    pg8::Gemm gm{YC, (const bf16_t*)(ws + WS_WCAT) + (size_t)layer * DM * YLD, YLD, YLD};
                    pg8::Sched<DM, 3, 0, 8, 512, 8, 1024, 16> S{G, bx};
                    pg8::EpiMerge E{Z, FACC, MG};
                    pg8::gemm_phase(tid_o, bx_o, G_o, lds3, gm, S, E);
                } else if (ls == 5) {
                    pg8::Gemm gm{MG, (const bf16_t*)(ws + WS_WOUT) + (size_t)layer * DM * DM, DM, DM};
                    pg8::Sched<DM, 1, 0, 16, 0, 0, 0, 0> S{G, bx};
                    pg8::EpiX<0> E{XBc, xout, XBc, RSSn, nullptr, nullptr, 0};
                    pg8::gemm_phase(tid_o, bx_o, G_o, lds3, gm, S, E);
                } else if (ls == 6) {
                    pg8::Gemm gm{XBc, (const bf16_t*)(ws + WS_WUP) + (size_t)layer * DFF2 * DM, XBLD, DM};
                    pg8::Sched<DFF2, 1, 0, 16, 0, 0, 0, 0> S{G, bx};
                    pg8::EpiUp E{ws, layer, cur ^ 1};
                    pg8::gemm_phase(tid_o, bx_o, G_o, lds3, gm, S, E);
                } else if (ls == 7) {
                    conv_fix(tid_o, bx_o, G_o, EB, ACT, KIN(19) + (size_t)layer * 3 * DFF2, KIN(20) + (size_t)layer * DFF2, N);
                } else if (ls == 8) {
                    pg8::Gemm gm{ACT, (const bf16_t*)(ws + WS_WDOWN) + (size_t)layer * DM * DFF, DFF, DFF};
                    pg8::Sched<DM, 1, 0, 44, 0, 0, 0, 0> S{G, bx};
                    pg8::EpiX<0> E{XBc, xout, XBc, RSSc, nullptr, nullptr, 0};
                    pg8::gemm_phase(tid_o, bx_o, G_o, lds3, gm, S, E);
                } else {
                    pg8::Gemm gm{XBc, (const bf16_t*)(ws + WS_WPG) + (size_t)layer * DM * WPGLD, XBLD, WPGLD};
                    pg8::Sched<DM, 2, 1024, 4, 0, 16, 0, 0> S{G, bx};
                    pg8::EpiX<1> E{XBc, xout, XBn, RSSn, RSSc, FACC, layer == 3 ? 1 : 0};
                    pg8::gemm_phase(tid_o, bx_o, G_o, lds3, gm, S, E);
                }
            }
        }
        if (step + 1 < step_hi) { if (first_sync) { cg::this_grid().sync(); first_sync = false; } else xcd_barrier(gbar); }
    }
}


extern "C" void kernel_launch(void* const* d_in, const int* in_sizes, int n_in, void* d_out, int out_size, void* d_ws, size_t ws_size, hipStream_t stream) {
    static int grid = 0;
    if (grid == 0) {
        if (n_in != 26 || ws_size < WS_END) { fprintf(stderr, "kernel_launch: unexpected n_in %d or ws_size %zu (< %zu)\n", n_in, ws_size, (size_t)WS_END); grid = -1; return; }
        int dev = 0, cus = 0, per_cu = 0;
        hipGetDevice(&dev); hipDeviceGetAttribute(&cus, hipDeviceAttributeMultiprocessorCount, dev);
        hipFuncSetAttribute((const void*)mega, hipFuncAttributeMaxDynamicSharedMemorySize, LDS_BYTES);
        hipOccupancyMaxActiveBlocksPerMultiprocessor(&per_cu, (const void*)mega, 512, LDS_BYTES);
        (void)hipGetLastError();
        if (per_cu < 1) per_cu = 1;
        grid = cus * 1;
        fprintf(stderr, "kernel_launch: cus %d per_cu %d grid %d ws %zu\n", cus, per_cu, grid, ws_size);
    }
    if (grid < 0) return;
    Params p{};
    for (int i = 0; i < 26; ++i) p.in[i] = (const float*)d_in[i];
    p.out = (float*)d_out; p.ws = (unsigned char*)d_ws;
#if ONE_LAUNCH
    p.lo = 0; p.hi = NSTEPS;
    if (hipMemsetAsync((unsigned char*)d_ws + WS_BAR, 0, XCD_BAR_WORDS * 4, stream) != hipSuccess) fprintf(stderr, "memset failed\n");
    void* args[] = {&p};
    hipError_t e = hipLaunchCooperativeKernel((const void*)mega, dim3(grid), dim3(512), args, LDS_BYTES, stream);
    if (e != hipSuccess) fprintf(stderr, "cooperative launch failed: %s\n", hipGetErrorString(e));
#else
    for (int s = 0; s < NSTEPS; ++s) { p.lo = s; p.hi = s + 1; hipLaunchKernelGGL(mega, dim3(grid), dim3(512), LDS_BYTES, stream, p); }
#endif
}
```

```cpp
#include <hip/hip_runtime.h>
#include <hip/hip_cooperative_groups.h>
#include <cstdio>
#include <cstdint>
namespace cg = cooperative_groups;

#ifndef ONE_LAUNCH
#define ONE_LAUNCH 1
#endif

#define LAS __attribute__((address_space(3)))
typedef unsigned short bf16_t;
typedef short bf16x8 __attribute__((ext_vector_type(8)));
typedef short s16x4 __attribute__((ext_vector_type(4)));
typedef float f32x4 __attribute__((ext_vector_type(4)));
typedef float f32x2 __attribute__((ext_vector_type(2)));
typedef float f32x16 __attribute__((ext_vector_type(16)));
typedef unsigned u32x4 __attribute__((ext_vector_type(4)));
typedef unsigned u32x2 __attribute__((ext_vector_type(2)));

constexpr int DM = 1024, DEPTH = 4, PLE = 256, DFF = 2816, DFF2 = 5632;
constexpr int OFF_POOL = 0, OFF_HQ = 512, OFF_HFF = 1024, OFF_HFB = 1536, OFF_HI = 2048, OFF_HG = 2560, OFF_AQ = 3072, OFF_AK = 4096, OFF_AV = 4352, OFF_GATE = 4608, INW = 7680;
constexpr int T = 16384;
constexpr int NGROUP = 3;
constexpr float EPS = 1e-6f;
constexpr int XBLD = 1280;
constexpr int YLD = 2048;
constexpr int WPGLD = 1280;

constexpr size_t MiB = 1u << 20;
constexpr size_t WS_CS = 0;
constexpr size_t WS_LB = 64 * 1024;
constexpr size_t WS_WIN = 1 * MiB;
constexpr size_t WS_WCAT = 61 * MiB;
constexpr size_t WS_WOUT = 77 * MiB;
constexpr size_t WS_WUP = 85 * MiB;
constexpr size_t WS_WDOWN = 129 * MiB;
constexpr size_t WS_WPG = 151 * MiB;
constexpr size_t WS_XB0 = 161 * MiB;
constexpr size_t WS_XB1 = 201 * MiB;
constexpr size_t WS_RSS = 241 * MiB;
constexpr size_t WS_Z = 243 * MiB;
constexpr size_t WS_YCAT = 483 * MiB;
constexpr size_t WS_MERGED = 547 * MiB;
constexpr size_t WS_ST = 579 * MiB;
constexpr size_t WS_VT = 643 * MiB;
constexpr size_t WS_DEC = 651 * MiB;
constexpr size_t WS_END = 652 * MiB;

constexpr int LDS_BYTES = 153600;

typedef __bf16 bf16x2_t __attribute__((ext_vector_type(2)));
__device__ __forceinline__ unsigned cvt_pk(float lo, float hi) { f32x2 v = {lo, hi}; bf16x2_t b = __builtin_convertvector(v, bf16x2_t); return __builtin_bit_cast(unsigned, b); }
__device__ __forceinline__ float bf2f(bf16_t h) { return __uint_as_float((unsigned)h << 16); }
__device__ __forceinline__ float bflo(unsigned w) { return __uint_as_float(w << 16); }
__device__ __forceinline__ float bfhi(unsigned w) { return __uint_as_float(w & 0xffff0000u); }
__device__ __forceinline__ bf16_t f2bf(float f) { return (bf16_t)(cvt_pk(f, 0.f) & 0xffffu); }
__device__ __forceinline__ float frcp(float x) { return __builtin_amdgcn_rcpf(x); }
__device__ __forceinline__ float sigm(float x) { return frcp(1.f + __expf(-x)); }
__device__ __forceinline__ int crow(int r, int hi) { return (r & 3) + 8 * (r >> 2) + 4 * hi; }
__device__ __forceinline__ f32x16 mfma32(bf16x8 x, bf16x8 y, f32x16 c) { return __builtin_amdgcn_mfma_f32_32x32x16_bf16(x, y, c, 0, 0, 0); }
__device__ __forceinline__ float wave_sum(float v) {
#pragma unroll
    for (int o = 1; o < 64; o <<= 1) v += __shfl_xor(v, o);
    return v;
}

__device__ __forceinline__ float gelu_tanh_e(float a) { const float e = __builtin_amdgcn_exp2f(a * (2.3022081984f + 0.1029432396f * (a * a))); return a - a * frcp(e + 1.f);   }

constexpr size_t WS_RSS_OFF = 241u * 1048576u, WS_ACT_OFF = 483u * 1048576u, WS_EB_OFF = (579u + 32u) * 1048576u;
extern __shared__ __attribute__((aligned(16))) unsigned char g_lds[];
namespace pg8 {
constexpr int BM = 256, BK = 64, HALF = 128, HTB = HALF * BK * 2, STAGE_BYTES = 8 * HTB, NXCD = 8, WGM = 8;
__host__ __device__ __forceinline__ int lds_byte(int r, int c) { const int st = (r >> 4) * 2 + (c >> 5), rr = r & 15, cc = c & 31, ob = rr * 64 + cc * 2; return st * 1024 + (ob ^ (((ob >> 9) & 1) << 5)); }
__host__ __device__ __forceinline__ void stage_rc(int b, int& R, int& C) { const int st = b / 1024, sb = b % 1024, swz = sb ^ (((sb >> 9) & 1) << 5); R = (st >> 1) * 16 + swz / 64; C = (st & 1) * 32 + (swz % 64) / 2; }
__host__ __device__ __forceinline__ int perm32(int rho) { const int n = rho >> 4, i = rho & 15; return 8 * (i >> 2) + 4 * n + (i & 3); }

struct Unit { int pm, pn, br, koff, nt; };
struct Gemm { const bf16_t* A; const bf16_t* Bt; int lda, ldb; };

template <int N_, int NBR, int K0, int T0, int K1, int T1, int K2, int T2>
struct Sched {
    int G, c;
    static constexpr int nM = 16384 / BM, nN = N_ / BM, nwg = nM * nN;
    __device__ __forceinline__ bool next(int i, Unit& u) const {
        const int ti = i / NBR, br = i - ti * NBR;
        const int L = ti * G + c; if (L >= nwg) return false;
        int wgid = L; { constexpr int q = nwg / NXCD, r = nwg % NXCD; const int xcd = wgid % NXCD, off = wgid / NXCD; wgid = (xcd < r ? xcd * (q + 1) : r * (q + 1) + (xcd - r) * q) + off; }
        constexpr int nig = WGM * nN; const int gid = wgid / nig, fm = gid * WGM, gsz = (nM - fm) < WGM ? (nM - fm) : WGM;
        u.pm = fm + ((wgid % nig) % gsz); u.pn = (wgid % nig) / gsz; u.br = br;
        u.koff = br == 0 ? K0 : (br == 1 ? K1 : K2); u.nt = br == 0 ? T0 : (br == 1 ? T1 : T2);
        return true;
    }
};

template <class Epi, class SchedT>
__device__ __forceinline__ void gemm_phase(const int TIDX, const int BIDX, const int GDIM, LAS unsigned char* lds, const Gemm g, const SchedT& S, const Epi& E) {
    const int tid = TIDX, wid = __builtin_amdgcn_readfirstlane(tid >> 6), lane = tid & 63, wr = wid >> 2, wc = wid & 3, fr = lane & 15, fq = lane >> 4;
    unsigned voffA[2], voffB[2];
#pragma unroll
    for (int i = 0; i < 2; ++i) { int R, C; stage_rc(tid * 16 + i * 8192, R, C); const int Rb = (R & ~31) + perm32(R & 31);
        voffA[i] = (unsigned)(R * g.lda + C) * 2u; voffB[i] = (unsigned)(Rb * g.ldb + C) * 2u; }
    const size_t kstep = (size_t)(BK * 2);
    const size_t hstepA = (size_t)HALF * g.lda * 2, hstepB = (size_t)HALF * g.ldb * 2;
    const size_t tstepA = 2 * hstepA, tstepB = 2 * hstepB;
    const unsigned ldsw = (unsigned)wid * 1024u;
    const int aoff = lds_byte(wr * 64 + fr, fq * 8), boff = lds_byte(wc * 32 + fr, fq * 8);
#define PG8_SA(b, h) (((b) * 2 + (h)) * HTB)
#define PG8_SB(b, h) ((4 + (b) * 2 + (h)) * HTB)
#define PG8_STAGE(bufoff, gbase, voff) do { _Pragma("unroll") for (int _i = 0; _i < 2; ++_i) \
        __builtin_amdgcn_global_load_lds((const unsigned*)((const char*)(gbase) + (voff)[_i]), (LAS unsigned*)(lds + (bufoff) + ldsw + _i * 8192), 16, 0, 0); } while (0)
#define PG8_LDA(dst, b, h) do { _Pragma("unroll") for (int m = 0; m < 4; ++m) _Pragma("unroll") for (int k = 0; k < 2; ++k) dst[m][k] = *(const LAS bf16x8*)(lds + PG8_SA(b, h) + aoff + m * 2048 + k * 1024); } while (0)
#define PG8_LDB(dst, b, h) do { _Pragma("unroll") for (int n = 0; n < 2; ++n) _Pragma("unroll") for (int k = 0; k < 2; ++k) dst[n][k] = *(const LAS bf16x8*)(lds + PG8_SB(b, h) + boff + n * 2048 + k * 1024); } while (0)
#define PG8_MMA(ai, bj, At, Bt) do { __builtin_amdgcn_s_setprio(1); _Pragma("unroll") for (int m = 0; m < 4; ++m) _Pragma("unroll") for (int n = 0; n < 2; ++n) _Pragma("unroll") for (int k = 0; k < 2; ++k) \
        acc[ai][bj][m][n] = __builtin_amdgcn_mfma_f32_16x16x32_bf16(Bt[n][k], At[m][k], acc[ai][bj][m][n], 0, 0, 0); __builtin_amdgcn_s_setprio(0); } while (0)
#define PG8_WAIT_V(n) asm volatile("s_waitcnt vmcnt(" #n ")" ::: "memory")
#define PG8_WAIT_L(n) asm volatile("s_waitcnt lgkmcnt(" #n ")" ::: "memory")
#define PG8_BAR __builtin_amdgcn_s_barrier()
#define PG8_SCHED __builtin_amdgcn_sched_barrier(0)
    Unit cur, nxt; int ui = 0;
    if (!S.next(0, cur)) return;
    f32x4 acc[2][2][4][2];
#pragma unroll
    for (int a = 0; a < 2; ++a)
#pragma unroll
        for (int b = 0; b < 2; ++b)
#pragma unroll
            for (int m = 0; m < 4; ++m)
#pragma unroll
                for (int n = 0; n < 2; ++n) acc[a][b][m][n] = (f32x4){0.f, 0.f, 0.f, 0.f};
    bf16x8 At[4][2], B0[2][2], B1[2][2];
    const char* cA = (const char*)g.A + (size_t)cur.pm * tstepA + (size_t)cur.koff * 2; const char* cB = (const char*)g.Bt + (size_t)cur.pn * tstepB + (size_t)cur.koff * 2;
    PG8_STAGE(PG8_SB(0, 0), cB, voffB); PG8_STAGE(PG8_SB(0, 1), cB + hstepB, voffB); PG8_STAGE(PG8_SA(0, 0), cA, voffA); PG8_STAGE(PG8_SA(0, 1), cA + hstepA, voffA);
    if (wr == 1) PG8_BAR;
    PG8_WAIT_V(2); PG8_BAR;
    PG8_STAGE(PG8_SB(1, 0), cB + kstep, voffB); PG8_STAGE(PG8_SA(1, 0), cA + kstep, voffA); PG8_STAGE(PG8_SB(1, 1), cB + hstepB + kstep, voffB);
    PG8_WAIT_V(6); PG8_BAR;
    for (;;) {
        const bool has_next = S.next(ui + 1, nxt);
        const int nt = cur.nt;
        const char* nA = has_next ? (const char*)g.A + (size_t)nxt.pm * tstepA + (size_t)nxt.koff * 2 : cA; const char* nB = has_next ? (const char*)g.Bt + (size_t)nxt.pn * tstepB + (size_t)nxt.koff * 2 : cB;
        for (int t = 0; t < nt; t += 2) {
            const bool last = (t == nt - 2);
            const char* a1 = cA + (size_t)(t + 1) * kstep;
            const char* a2 = last ? nA : cA + (size_t)(t + 2) * kstep; const char* b2 = last ? nB : cB + (size_t)(t + 2) * kstep;
            const char* a3 = a2 + kstep; const char* b3 = b2 + kstep;
            PG8_LDB(B0, 0, 0); PG8_LDB(B1, 0, 1); PG8_SCHED; PG8_LDA(At, 0, 0); PG8_STAGE(PG8_SA(1, 1), a1 + hstepA, voffA);
            PG8_WAIT_V(8); PG8_WAIT_L(0); PG8_BAR; PG8_MMA(0, 0, At, B0); PG8_MMA(0, 1, At, B1); PG8_BAR; PG8_SCHED;
            PG8_LDA(At, 0, 1); PG8_STAGE(PG8_SB(0, 0), b2, voffB); PG8_STAGE(PG8_SB(0, 1), b2 + hstepB, voffB); PG8_STAGE(PG8_SA(0, 0), a2, voffA);
            PG8_WAIT_V(8); PG8_WAIT_L(0); PG8_BAR; PG8_MMA(1, 0, At, B0); PG8_MMA(1, 1, At, B1); PG8_BAR; PG8_SCHED;
            PG8_LDB(B0, 1, 0); PG8_LDB(B1, 1, 1); PG8_SCHED; PG8_LDA(At, 1, 0); PG8_STAGE(PG8_SA(0, 1), a2 + hstepA, voffA);
            PG8_WAIT_V(8); PG8_WAIT_L(0); PG8_BAR; PG8_MMA(0, 0, At, B0); PG8_MMA(0, 1, At, B1); PG8_BAR; PG8_SCHED;
            PG8_LDA(At, 1, 1); PG8_STAGE(PG8_SB(1, 0), b3, voffB); PG8_STAGE(PG8_SB(1, 1), b3 + hstepB, voffB); PG8_STAGE(PG8_SA(1, 0), a3, voffA);
            PG8_WAIT_V(8); PG8_WAIT_L(0); PG8_BAR; PG8_MMA(1, 0, At, B0); PG8_MMA(1, 1, At, B1); PG8_BAR; PG8_SCHED;
        }
        if (wr == 0) PG8_BAR;
        E(acc, cur, wr, wc, fr, fq);
        if (!has_next) break;
#pragma unroll
        for (int a = 0; a < 2; ++a)
#pragma unroll
            for (int b = 0; b < 2; ++b)
#pragma unroll
                for (int m = 0; m < 4; ++m)
#pragma unroll
                    for (int n = 0; n < 2; ++n) acc[a][b][m][n] = (f32x4){0.f, 0.f, 0.f, 0.f};
        cur = nxt; cA = nA; cB = nB; ++ui;
        if (wr == 1) PG8_BAR;
    }
    PG8_WAIT_V(0);
    PG8_BAR;
#undef PG8_SA
#undef PG8_SB
#undef PG8_STAGE
#undef PG8_LDA
#undef PG8_LDB
#undef PG8_MMA
#undef PG8_WAIT_V
#undef PG8_WAIT_L
#undef PG8_BAR
#undef PG8_SCHED
}

__device__ __forceinline__ float row_rinv(const float* rss, int row) {
    const f32x4* p = (const f32x4*)(rss + (size_t)row * 16);
    const f32x4 a = p[0], b = p[1], c = p[2], d = p[3];
    const float s = ((a[0] + a[1]) + (a[2] + a[3])) + ((b[0] + b[1]) + (b[2] + b[3])) + ((c[0] + c[1]) + (c[2] + c[3])) + ((d[0] + d[1]) + (d[2] + d[3]));
    return rsqrtf(s * (1.0f / DM) + EPS);
}
__device__ __forceinline__ float row_rinv_q(const float* rss, int row, int fq) {
    const f32x4 a = ((const f32x4*)(rss + (size_t)row * 16))[fq];
    float s = (a[0] + a[1]) + (a[2] + a[3]);
    s += __shfl_xor(s, 16); s += __shfl_xor(s, 32);
    return rsqrtf(s * (1.0f / DM) + EPS);
}
struct EpiScale {
    bf16_t* O; int ldc; const float* rss; int sig_pn;
    __device__ __forceinline__ void operator()(const f32x4 (&acc)[2][2][4][2], const Unit& u, int wr, int wc, int fr, int fq) const {
        const int col0 = u.pn * BM + wc * 32 + 8 * fq; const bool sg = u.pn >= sig_pn;
#pragma unroll
        for (int ai = 0; ai < 2; ++ai)
#pragma unroll
            for (int m = 0; m < 4; ++m) { const int row = u.pm * BM + ai * HALF + wr * 64 + m * 16 + fr; const float r = row_rinv(rss, row);
                bf16_t* rowp = O + (size_t)row * ldc + col0;
#pragma unroll
                for (int bj = 0; bj < 2; ++bj) { f32x4 v0 = acc[ai][bj][m][0] * r, v1 = acc[ai][bj][m][1] * r;
                    if (sg) {
#pragma unroll
                        for (int e = 0; e < 4; ++e) { v0[e] = sigm(v0[e]); v1[e] = sigm(v1[e]); } }
                    u32x4 w; w.x = cvt_pk(v0[0], v0[1]); w.y = cvt_pk(v0[2], v0[3]); w.z = cvt_pk(v1[0], v1[1]); w.w = cvt_pk(v1[2], v1[3]);
                    __builtin_nontemporal_store(w, (u32x4*)(rowp + bj * HALF)); }
                asm volatile("" ::: "memory"); }
    }
};
struct EpiMerge {
    const bf16_t* Z; bf16_t* facc; bf16_t* merged;
    __device__ __forceinline__ void operator()(const f32x4 (&acc)[2][2][4][2], const Unit& u, int wr, int wc, int fr, int fq) const {
        const int col0 = u.pn * BM + wc * 32 + 8 * fq;
#pragma unroll
        for (int ai = 0; ai < 2; ++ai)
#pragma unroll
            for (int m = 0; m < 4; ++m) { const int row = u.pm * BM + ai * HALF + wr * 64 + m * 16 + fr;
#pragma unroll
                for (int bj = 0; bj < 2; ++bj) { const int col = col0 + bj * HALF;
                    const u32x4 gw = *(const u32x4*)(Z + (size_t)row * INW + OFF_GATE + u.br * DM + col);
                    f32x4 v0 = acc[ai][bj][m][0], v1 = acc[ai][bj][m][1];
                    v0[0] *= bflo(gw.x); v0[1] *= bfhi(gw.x); v0[2] *= bflo(gw.y); v0[3] *= bfhi(gw.y);
                    v1[0] *= bflo(gw.z); v1[1] *= bfhi(gw.z); v1[2] *= bflo(gw.w); v1[3] *= bfhi(gw.w);
                    bf16_t* fp = facc + (size_t)row * DM + col;
                    if (u.br > 0) { const u32x4 pw = *(const u32x4*)fp; v0[0] += bflo(pw.x); v0[1] += bfhi(pw.x); v0[2] += bflo(pw.y); v0[3] += bfhi(pw.y); v1[0] += bflo(pw.z); v1[1] += bfhi(pw.z); v1[2] += bflo(pw.w); v1[3] += bfhi(pw.w); }
                    if (u.br < 2) { u32x4 w; w.x = cvt_pk(v0[0], v0[1]); w.y = cvt_pk(v0[2], v0[3]); w.z = cvt_pk(v1[0], v1[1]); w.w = cvt_pk(v1[2], v1[3]); *(u32x4*)fp = w; }
                    else { u32x4 w; w.x = cvt_pk(v0[0], v0[1]); w.y = cvt_pk(v0[2], v0[3]); w.z = cvt_pk(v1[0], v1[1]); w.w = cvt_pk(v1[2], v1[3]);
                        *(u32x4*)(merged + (size_t)row * DM + col) = w; } }
                asm volatile("" ::: "memory"); }
    }
};
template <int MODE> struct EpiX {
    const bf16_t* baseb; float* out; bf16_t* xb; float* rss_out; const float* rss_in; bf16_t* facc; int wout;
    __device__ __forceinline__ void operator()(const f32x4 (&acc)[2][2][4][2], const Unit& u, int wr, int wc, int fr, int fq) const {
        const int col0 = u.pn * BM + wc * 32 + 8 * fq;
#pragma unroll
        for (int ai = 0; ai < 2; ++ai)
#pragma unroll
            for (int m = 0; m < 4; ++m) { const int row = u.pm * BM + ai * HALF + wr * 64 + m * 16 + fr;
                if (MODE == 1 && u.br == 0) {
#pragma unroll
                    for (int bj = 0; bj < 2; ++bj) { bf16_t* fp = facc + (size_t)row * DM + col0 + bj * HALF; const f32x4 a0 = acc[ai][bj][m][0], a1 = acc[ai][bj][m][1]; u32x4 w; w.x = cvt_pk(a0[0], a0[1]); w.y = cvt_pk(a0[2], a0[3]); w.z = cvt_pk(a1[0], a1[1]); w.w = cvt_pk(a1[2], a1[3]); *(u32x4*)fp = w; }
                } else {
                    float r = 1.f; if (MODE == 1) r = row_rinv(rss_in, row);
                    float ss = 0.f;
#pragma unroll
                    for (int bj = 0; bj < 2; ++bj) { const int col = col0 + bj * HALF; const size_t off = (size_t)row * DM + col;
                        f32x4 v0 = acc[ai][bj][m][0], v1 = acc[ai][bj][m][1];
                        if (MODE == 1) { const u32x4 pw = *(const u32x4*)(facc + off); const f32x4 p0 = (f32x4){bflo(pw.x), bfhi(pw.x), bflo(pw.y), bfhi(pw.y)}, p1 = (f32x4){bflo(pw.z), bfhi(pw.z), bflo(pw.w), bfhi(pw.w)};
#pragma unroll
                            for (int e = 0; e < 4; ++e) { v0[e] = sigm(v0[e] * r) * p0[e]; v1[e] = sigm(v1[e] * r) * p1[e]; } }
                        const u32x4 bw = *(const u32x4*)(baseb + (size_t)row * XBLD + col);
                        v0[0] += bflo(bw.x); v0[1] += bfhi(bw.x); v0[2] += bflo(bw.y); v0[3] += bfhi(bw.y); v1[0] += bflo(bw.z); v1[1] += bfhi(bw.z); v1[2] += bflo(bw.w); v1[3] += bfhi(bw.w);
                        if (wout) { *(f32x4*)(out + off) = v0; *(f32x4*)(out + off + 4) = v1; }
                        ss += (v0[0] * v0[0] + v0[1] * v0[1]) + (v0[2] * v0[2] + v0[3] * v0[3]) + (v1[0] * v1[0] + v1[1] * v1[1]) + (v1[2] * v1[2] + v1[3] * v1[3]);
                        u32x4 w; w.x = cvt_pk(v0[0], v0[1]); w.y = cvt_pk(v0[2], v0[3]); w.z = cvt_pk(v1[0], v1[1]); w.w = cvt_pk(v1[2], v1[3]);
                        *(u32x4*)(xb + (size_t)row * XBLD + col) = w; }
                    ss += __shfl_xor(ss, 16); ss += __shfl_xor(ss, 32);
                    if (fq == 0) rss_out[(size_t)row * 16 + u.pn * 4 + wc] = ss;
                }
                asm volatile("" ::: "memory"); }
    }
};
#define PIN_ACC_HALF(A) asm volatile("" : "+v"(acc[A][0][0][0]), "+v"(acc[A][0][0][1]), "+v"(acc[A][0][1][0]), "+v"(acc[A][0][1][1]), "+v"(acc[A][0][2][0]), "+v"(acc[A][0][2][1]), "+v"(acc[A][0][3][0]), "+v"(acc[A][0][3][1]), \
    "+v"(acc[A][1][0][0]), "+v"(acc[A][1][0][1]), "+v"(acc[A][1][1][0]), "+v"(acc[A][1][1][1]), "+v"(acc[A][1][2][0]), "+v"(acc[A][1][2][1]), "+v"(acc[A][1][3][0]), "+v"(acc[A][1][3][1]))
#define PIN_ACC() do { PIN_ACC_HALF(0); PIN_ACC_HALF(1); } while (0)
struct EpiUp {
    unsigned char* ws; int layer, rsel;
    __device__ __forceinline__ void operator()(f32x4 (&acc)[2][2][4][2], const Unit& u, int wr, int wc, int fr, int fq) const {
        { const int lane_ = (int)__builtin_amdgcn_mbcnt_hi(~0u, __builtin_amdgcn_mbcnt_lo(~0u, 0u)); fr = lane_ & 15; fq = lane_ >> 4; }
        asm volatile("" : "+v"(fr), "+v"(fq));
        const unsigned row0 = (unsigned)(u.pm * BM + wr * 64 + fr);
        typedef __attribute__((address_space(4))) const unsigned char* kap_t; const kap_t ka_ = (kap_t)__builtin_amdgcn_kernarg_segment_ptr();
        const float* cw = *(const float* const volatile __attribute__((address_space(4)))*)(ka_ + 8 * 19) + (size_t)layer * 3 * DFF2;
        const float* cb = *(const float* const volatile __attribute__((address_space(4)))*)(ka_ + 8 * 20) + (size_t)layer * DFF2;
        unsigned char* ldsx = g_lds + 132096;
        const char* rssb = (const char*)(ws + WS_RSS_OFF + (size_t)rsel * (16384u * 64u)); char* actb = (char*)(ws + WS_ACT_OFF); char* ebb = (char*)(ws + WS_EB_OFF);
        {
            float* rtab = (float*)(g_lds + 148480 + (wr * 4 + wc) * 512);
            const unsigned lrow = (unsigned)(u.pm * BM + wr * 64) + (unsigned)(fq * 16 + fr);
            rtab[fq * 16 + fr] = row_rinv((const float*)rssb, (int)lrow); rtab[64 + fq * 16 + fr] = row_rinv((const float*)rssb, (int)(lrow + HALF));
            asm volatile("s_waitcnt lgkmcnt(0)" ::: "memory");
#pragma unroll
            for (int ai = 0; ai < 2; ++ai)
#pragma unroll
                for (int m = 0; m < 4; ++m) { const float r = rtab[ai * 64 + m * 16 + fr];
#pragma unroll
                    for (int bj = 0; bj < 2; ++bj) { acc[ai][bj][m][0] *= r; acc[ai][bj][m][1] *= r; } } }
        PIN_ACC();
        unsigned char* sl = ldsx + (wr * 4 + wc) * 2048 + fr * 32 + fq * 8;
#pragma unroll
        for (int n = 0; n < 2; ++n) {
            const unsigned ch = (unsigned)(u.pn * 128 + wc * 32 + 8 * fq + 4 * n);
#pragma unroll
            for (int bj = 0; bj < 2; ++bj) {
                const char* cwb = (const char*)cw; const unsigned coff = (bj * DFF + ch) * 4u;
                const f32x4 w0 = *(const f32x4*)(cwb + coff), w1 = *(const f32x4*)(cwb + coff + DFF2 * 4u), w2 = *(const f32x4*)(cwb + coff + 2u * DFF2 * 4u), bb = *(const f32x4*)((const char*)cb + coff);
#pragma unroll
                for (int ai = 0; ai < 2; ++ai) {
                    const unsigned blk = (unsigned)(u.pm * 4 + ai * 2 + wr);
                    u32x2 pk[4];
#pragma unroll
                    for (int m = 0; m < 4; ++m) { const f32x4 x = acc[ai][bj][m][n]; pk[m].x = cvt_pk(x[0], x[1]); pk[m].y = cvt_pk(x[2], x[3]); *(u32x2*)(sl + m * 512) = pk[m]; }
                    { const unsigned dummy = 256u * 4u * DFF2 * 2u + (unsigned)(fq * 16 + fr) * 8u;
                      const unsigned e0 = fr < 2 ? ((blk * 4u + (unsigned)fr) * DFF2 + bj * DFF + ch) * 2u : dummy, e3 = fr >= 14 ? ((blk * 4u + (unsigned)(fr - 12)) * DFF2 + bj * DFF + ch) * 2u : dummy;
                      *(u32x2*)(ebb + e0) = pk[0]; *(u32x2*)(ebb + e3) = pk[3]; }
                    asm volatile("s_waitcnt lgkmcnt(0)" ::: "memory");
#pragma unroll
                    for (int m = 0; m < 4; ++m) { const f32x4 x = acc[ai][bj][m][n];
                        const u32x2 pw = *(const u32x2*)(sl + m * 512 - 32), nw = *(const u32x2*)(sl + m * 512 + 32);
                        const f32x4 pv = (f32x4){bflo(pw.x), bfhi(pw.x), bflo(pw.y), bfhi(pw.y)}, nv = (f32x4){bflo(nw.x), bfhi(nw.x), bflo(nw.y), bfhi(nw.y)};
                        acc[ai][bj][m][n] = pv * w0 + x * w1 + nv * w2 + bb; }
                    asm volatile("s_waitcnt lgkmcnt(0)" ::: "memory");
                    PIN_ACC();
                }
            }
        }
        {
            const unsigned ch0 = (unsigned)(u.pn * 128 + wc * 32 + 8 * fq);
#pragma unroll
            for (int ai = 0; ai < 2; ++ai)
#pragma unroll
                for (int m = 0; m < 4; ++m) { const unsigned row = row0 + ai * HALF + m * 16;
                    const f32x4 ca0 = acc[ai][0][m][0], cg0 = acc[ai][1][m][0], ca1 = acc[ai][0][m][1], cg1 = acc[ai][1][m][1];
                    u32x4 w;
                    w.x = cvt_pk(gelu_tanh_e(ca0[0]) * cg0[0], gelu_tanh_e(ca0[1]) * cg0[1]); w.y = cvt_pk(gelu_tanh_e(ca0[2]) * cg0[2], gelu_tanh_e(ca0[3]) * cg0[3]);
                    w.z = cvt_pk(gelu_tanh_e(ca1[0]) * cg1[0], gelu_tanh_e(ca1[1]) * cg1[1]); w.w = cvt_pk(gelu_tanh_e(ca1[2]) * cg1[2], gelu_tanh_e(ca1[3]) * cg1[3]);
                    *(u32x4*)(actb + (row * DFF + ch0) * 2u) = w; }
        }
    }
};
}

struct Params { const float* in[26]; float* out; unsigned char* ws; int lo, hi; };

__device__ __forceinline__ void transpose_item(const float* W, int K, int N, bf16_t* WT, int ldwt, int kdst, const float* gk, float sc_lo, int nlo, int nhi, float* scr, int item, int lane, bool permup = false) {
    const int nblk = N / 32, kb = item / nblk, nb = item % nblk, k0 = 64 * kb, n0 = 32 * nb;
    const float sc = (n0 >= nlo && n0 < nhi) ? sc_lo : 1.f;
#pragma unroll 8
    for (int i = 0; i < 32; ++i) { const int kk = 2 * i + (lane >> 5); float g = gk ? gk[k0 + kk] : 1.f; scr[kk * 33 + (lane & 31)] = W[(size_t)(k0 + kk) * N + n0 + (lane & 31)] * g * sc; }
    asm volatile("s_waitcnt lgkmcnt(0)" ::: "memory");
    const int c = lane & 7;
    int drow0 = n0; if (permup) { const int isg = n0 >= DFF ? 1 : 0, chn = n0 - isg * DFF; drow0 = (chn >> 7) * 256 + isg * 128 + (chn & 127); }
#pragma unroll
    for (int j = 0; j < 4; ++j) { const int n = (lane >> 3) + 8 * j; const float* s = scr + (8 * c) * 33 + n;
        u32x4 o; o.x = cvt_pk(s[0 * 33], s[1 * 33]); o.y = cvt_pk(s[2 * 33], s[3 * 33]); o.z = cvt_pk(s[4 * 33], s[5 * 33]); o.w = cvt_pk(s[6 * 33], s[7 * 33]);
        *(u32x4*)(WT + (size_t)(drow0 + n) * ldwt + kdst + k0 + 8 * c) = o; }
    asm volatile("s_waitcnt lgkmcnt(0)" ::: "memory");
}

typedef __attribute__((address_space(4))) const unsigned char* kaptr_t;
#define KIN0(i) (*(const float* const volatile __attribute__((address_space(4)))*)(ka + 8 * (i)))
__device__ __forceinline__ void phase0(const int TIDX, const int BIDX, const int GDIM, kaptr_t ka, unsigned char* lds) {
    const int tid = TIDX, lane = tid & 63, wave = tid >> 6;
    unsigned char* ws = *(unsigned char* const volatile __attribute__((address_space(4)))*)(ka + 8 * 27);
    const int gthreads = GDIM * 512, gtid = BIDX * 512 + tid;
    if (gtid < 128 * 16) { const int p = gtid >> 4, i = gtid & 15; const float invf = exp2f(-(float)i * (13.287712379549449f / 16.0f)); const float ang = (float)p * invf;
        ((f32x2*)(ws + WS_CS))[gtid] = (f32x2){cosf(ang), sinf(ang)}; }
    if (gtid >= 2048 && gtid < 2048 + 1024) { const int q = gtid - 2048, dir = q >> 9, ch = q & 511; const float* raw = KIN0(dir ? 9 : 8);
        float v[4], mx = -1e30f;
#pragma unroll
        for (int l = 0; l < 4; ++l) { v[l] = raw[l * 512 + ch]; mx = fmaxf(mx, v[l]); }
        float s = 0.f;
#pragma unroll
        for (int l = 0; l < 4; ++l) { v[l] = expf(v[l] - mx); s += v[l]; }
        float run = 0.f; float* LB = (float*)(ws + WS_LB);
#pragma unroll
        for (int l = 0; l < 4; ++l) { if (l > 0) run += v[l] / s; LB[(l * 2 + dir) * 512 + ch] = run; } }
    float* scr = (float*)(lds + wave * 16384);
    const int gw = BIDX * 8 + wave, NGW = GDIM * 8;
    constexpr int I_IN = 16 * 240, I_UP = 16 * 176, I_DN = 44 * 32, I_HG = 8 * 32, I_AT = 16 * 32, I_OUT = 16 * 32, I_PG = 16 * 32, I_PL = 4 * 32;
    constexpr int PER_L = I_IN + I_UP + I_DN + I_HG + I_AT + I_OUT + I_PG + I_PL;
    for (int it = gw; it < 4 * PER_L; it += NGW) {
        const int l = it / PER_L; int r = it % PER_L;
        if (r < I_IN) { transpose_item(KIN0(5) + (size_t)l * DM * INW, DM, INW, (bf16_t*)(ws + WS_WIN) + (size_t)l * INW * DM, DM, 0, KIN0(4) + l * DM, 0.08838834764831845f, OFF_HQ, OFF_HFF, scr, r, lane); continue; } r -= I_IN;
        if (r < I_UP) { transpose_item(KIN0(18) + (size_t)l * DM * DFF2, DM, DFF2, (bf16_t*)(ws + WS_WUP) + (size_t)l * DFF2 * DM, DM, 0, KIN0(17) + l * DM, 1.f, 0, 0, scr, r, lane, true); continue; } r -= I_UP;
        if (r < I_DN) { transpose_item(KIN0(21) + (size_t)l * DFF * DM, DFF, DM, (bf16_t*)(ws + WS_WDOWN) + (size_t)l * DM * DFF, DFF, 0, nullptr, 1.f, 0, 0, scr, r, lane); continue; } r -= I_DN;
        if (r < I_HG) { transpose_item(KIN0(14) + (size_t)l * 512 * DM, 512, DM, (bf16_t*)(ws + WS_WCAT) + (size_t)l * DM * YLD, YLD, 512, nullptr, 1.f, 0, 0, scr, r, lane); continue; } r -= I_HG;
        if (r < I_AT) { transpose_item(KIN0(15) + (size_t)l * DM * DM, DM, DM, (bf16_t*)(ws + WS_WCAT) + (size_t)l * DM * YLD, YLD, 1024, nullptr, 1.f, 0, 0, scr, r, lane); continue; } r -= I_AT;
        if (r < I_OUT) { transpose_item(KIN0(16) + (size_t)l * DM * DM, DM, DM, (bf16_t*)(ws + WS_WOUT) + (size_t)l * DM * DM, DM, 0, nullptr, 1.f, 0, 0, scr, r, lane); continue; } r -= I_OUT;
        if (r < I_PG) { transpose_item(KIN0(23) + (size_t)l * DM * DM, DM, DM, (bf16_t*)(ws + WS_WPG) + (size_t)l * DM * WPGLD, WPGLD, 0, KIN0(22) + l * DM, 1.f, 0, 0, scr, r, lane); continue; } r -= I_PG;
        transpose_item(KIN0(24) + (size_t)l * PLE * DM, PLE, DM, (bf16_t*)(ws + WS_WPG) + (size_t)l * DM * WPGLD, WPGLD, 1024, nullptr, 1.f, 0, 0, scr, r, lane);
    }
    for (int o = gtid; o < 4 * 512 * 1024; o += gthreads) {
        const int n = o & 1023, gc = (o >> 10) & 511, l = o >> 19, g = gc >> 7;
        const float* pw = KIN0(6) + ((size_t)l * 512 + gc) * 128; const float* sc = KIN0(7) + l * 512 + g * 128; const float* wb = KIN0(13) + ((size_t)l * 512 + g * 128) * DM + n;
        float s = 0.f;
#pragma unroll 8
        for (int d = 0; d < 128; ++d) s += pw[d] * sc[d] * wb[(size_t)d * DM];
        ((bf16_t*)(ws + WS_WCAT))[((size_t)l * DM + n) * YLD + gc] = f2bf(s);
    }
}

__device__ __forceinline__ void group_init(const int TIDX, const int BIDX, const int GDIM, const float* xin, bf16_t* xb, float* rss) {
    const int lane = TIDX & 63; const int gw = BIDX * 8 + (TIDX >> 6), NGW = GDIM * 8;
    for (int row = gw; row < T; row += NGW) {
        const f32x4* xr = (const f32x4*)(xin + (size_t)row * DM) + lane; float s = 0.f;
        f32x4 v[4];
#pragma unroll
        for (int j = 0; j < 4; ++j) { v[j] = xr[64 * j]; s += (v[j][0] * v[j][0] + v[j][1] * v[j][1]) + (v[j][2] * v[j][2] + v[j][3] * v[j][3]); }
        s = wave_sum(s);
#pragma unroll
        for (int j = 0; j < 4; ++j) { u32x2 w; w.x = cvt_pk(v[j][0], v[j][1]); w.y = cvt_pk(v[j][2], v[j][3]); *(u32x2*)(xb + (size_t)row * XBLD + 4 * lane + 256 * j) = w; }
        if (lane < 16) rss[(size_t)row * 16 + lane] = lane == 0 ? s : 0.f;
    }
}
__device__ __forceinline__ void final_norm(const int TIDX, const int BIDX, const int GDIM, float* out, const float* rss, const float* gfin) {
    const int lane = TIDX & 63; const int gw = BIDX * 8 + (TIDX >> 6), NGW = GDIM * 8;
    for (int row = gw; row < T; row += NGW) {
        const float r = pg8::row_rinv(rss, row);
        f32x4* xr = (f32x4*)(out + (size_t)row * DM) + lane; const f32x4* gp = (const f32x4*)gfin + lane;
#pragma unroll
        for (int j = 0; j < 4; ++j) { f32x4 v = xr[64 * j]; const f32x4 g = gp[64 * j]; v = v * r * g;
            xr[64 * j] = v; }
    }
}

__device__ __forceinline__ void prep_p(const int TIDX, const int BIDX, const int GDIM, const float* pin, bf16_t* xb) {
    const int lane = TIDX & 63; const int gw = BIDX * 8 + (TIDX >> 6), NGW = GDIM * 8;
    for (int row = gw; row < T; row += NGW) { const f32x4 v = ((const f32x4*)(pin + (size_t)row * PLE))[lane];
        u32x2 w; w.x = cvt_pk(v[0], v[1]); w.y = cvt_pk(v[2], v[3]); *(u32x2*)(xb + (size_t)row * XBLD + 1024 + 4 * lane) = w; }
}
__device__ __forceinline__ void prep_qk(const int TIDX, const int BIDX, const int GDIM, bf16_t* Z, const f32x2* cs, const float* gq, const float* gk, int N) {
    const int gthreads = GDIM * 512, gtid = BIDX * 512 + TIDX;
    for (int it = gtid; it < T * 40; it += gthreads) {
        const int a = it & 1, hv = (it >> 1) % 20, row = (it >> 1) / 20;
        const bool isq = hv < 16; const int coloff = isq ? OFF_AQ + hv * 64 : OFF_AK + (hv - 16) * 64;
        bf16_t* p = Z + (size_t)row * INW + coloff + a * 32;
        u32x4 w[4];
#pragma unroll
        for (int j = 0; j < 4; ++j) w[j] = ((const u32x4*)p)[j];
        float x[32];
#pragma unroll
        for (int j = 0; j < 4; ++j) { x[8 * j + 0] = bflo(w[j].x); x[8 * j + 1] = bfhi(w[j].x); x[8 * j + 2] = bflo(w[j].y); x[8 * j + 3] = bfhi(w[j].y);
            x[8 * j + 4] = bflo(w[j].z); x[8 * j + 5] = bfhi(w[j].z); x[8 * j + 6] = bflo(w[j].w); x[8 * j + 7] = bfhi(w[j].w); }
        float ss = 0.f;
#pragma unroll
        for (int d = 0; d < 32; ++d) ss += x[d] * x[d];
        ss += __shfl_xor(ss, 1);
        float r = rsqrtf(ss * (1.f / 64.f) + EPS); if (isq) r *= 0.125f * 1.4426950408889634f;
        const float* g = (isq ? gq : gk) + a * 32;
        const int t = row % N; const int pos = a == 0 ? (t >> 6) : (t & 63);
        const f32x2* c = cs + pos * 16;
        float y[32];
#pragma unroll
        for (int i = 0; i < 16; ++i) { const f32x2 cc = c[i]; const float x1 = x[i] * g[i], x2 = x[16 + i] * g[16 + i];
            y[i] = (x1 * cc.x - x2 * cc.y) * r; y[16 + i] = (x2 * cc.x + x1 * cc.y) * r; }
#pragma unroll
        for (int j = 0; j < 4; ++j) { u32x4 o; o.x = cvt_pk(y[8 * j], y[8 * j + 1]); o.y = cvt_pk(y[8 * j + 2], y[8 * j + 3]); o.z = cvt_pk(y[8 * j + 4], y[8 * j + 5]); o.w = cvt_pk(y[8 * j + 6], y[8 * j + 7]);
            ((u32x4*)p)[j] = o; }
    }
}
__device__ __forceinline__ void prep_vt(const int TIDX, const int BIDX, const int GDIM, const bf16_t* Z, bf16_t* VT, int N, unsigned char* lds) {
    const int tid = TIDX; bf16_t* Ts = (bf16_t*)lds;
    const int nc = N / 64;
    for (int it = BIDX; it < (T / 64) * 4; it += GDIM) {
        const int kvh = it & 3, cgl = it >> 2, seq = cgl / nc, c = cgl % nc;
        { const int t = tid >> 3, ch = tid & 7; const u32x4 v = *(const u32x4*)(Z + (size_t)(cgl * 64 + t) * INW + OFF_AV + kvh * 64 + ch * 8); *(u32x4*)(Ts + t * 72 + ch * 8) = v; }
        __syncthreads();
        { const int d = tid >> 3, ch = tid & 7; unsigned short e[8];
#pragma unroll
            for (int i = 0; i < 8; ++i) e[i] = Ts[(ch * 8 + i) * 72 + d];
            u32x4 o; o.x = e[0] | ((unsigned)e[1] << 16); o.y = e[2] | ((unsigned)e[3] << 16); o.z = e[4] | ((unsigned)e[5] << 16); o.w = e[6] | ((unsigned)e[7] << 16);
            *(u32x4*)(VT + (size_t)((seq * 4 + kvh) * 64 + d) * N + c * 64 + ch * 8) = o; }
        __syncthreads();
    }
}
template <int HALFW> __device__ __forceinline__ void pool_item(const bf16_t* Z, bf16_t* Y, int N, int row, int c8) {
    const int t = row % N;
    float s[8];
#pragma unroll
    for (int e = 0; e < 8; ++e) s[e] = 0.f;
    u32x4 w[2 * HALFW];
#pragma unroll
    for (int k = 0; k < 2 * HALFW; ++k) { const int q = t - HALFW + k; const bool ok = q >= 0 && q < N;
        w[k] = ok ? *(const u32x4*)(Z + (size_t)(row - HALFW + k) * INW + OFF_POOL + c8) : (u32x4){0u, 0u, 0u, 0u}; }
#pragma unroll
    for (int k = 0; k < 2 * HALFW; ++k) { s[0] += bflo(w[k].x); s[1] += bfhi(w[k].x); s[2] += bflo(w[k].y); s[3] += bfhi(w[k].y); s[4] += bflo(w[k].z); s[5] += bfhi(w[k].z); s[6] += bflo(w[k].w); s[7] += bfhi(w[k].w); }
    const int lo = t - HALFW < 0 ? 0 : t - HALFW, hi = t + HALFW > N ? N : t + HALFW;
    const float ic = frcp((float)(hi - lo));
    const u32x4 c = w[HALFW];
    const float u[8] = {bflo(c.x), bfhi(c.x), bflo(c.y), bfhi(c.y), bflo(c.z), bfhi(c.z), bflo(c.w), bfhi(c.w)};
    u32x4 o; o.x = cvt_pk(s[0] * ic - u[0], s[1] * ic - u[1]); o.y = cvt_pk(s[2] * ic - u[2], s[3] * ic - u[3]); o.z = cvt_pk(s[4] * ic - u[4], s[5] * ic - u[5]); o.w = cvt_pk(s[6] * ic - u[6], s[7] * ic - u[7]);
    *(u32x4*)(Y + (size_t)row * YLD + c8) = o;
}
__device__ __forceinline__ void prep_pool(const int TIDX, const int BIDX, const int GDIM, const bf16_t* Z, bf16_t* Y, int N) {
    const int gthreads = GDIM * 512, gtid = BIDX * 512 + TIDX;
    for (int it = gtid; it < T * 64; it += gthreads) {
        const int g = it / (T * 16), rem = it % (T * 16), row = rem >> 4, c8 = g * 128 + (rem & 15) * 8;
        if (g == 0) pool_item<1>(Z, Y, N, row, c8); else if (g == 1) pool_item<2>(Z, Y, N, row, c8); else if (g == 2) pool_item<4>(Z, Y, N, row, c8); else pool_item<8>(Z, Y, N, row, c8);
    }
}

__device__ __forceinline__ void hg_pass1(const int TIDX, const int BIDX, const int GDIM, const bf16_t* Z, bf16_t* ST, float* DEC, const float* LBl  , int N, unsigned char* lds) {
    const int tid = TIDX, lane = tid & 63, wid = tid >> 6, r32 = lane & 31, hi = lane >> 5;
    const int ch = tid & 127, qq = tid >> 7, nc = N / 64;
    bf16_t* Ktf = (bf16_t*)lds;
    bf16_t* Ktb = (bf16_t*)(lds + 18432);
    bf16_t* Vt = (bf16_t*)(lds + 36864);
    float* qtot = (float*)(lds + 55296);
    for (int u = BIDX; u < (T / 64) * 4; u += GDIM) {
        const int h = u & 3, cgl = u >> 2, seq = cgl / nc, c = cgl % nc, r0 = cgl * 64;
        const float lbf = LBl[h * 128 + ch], lbb = LBl[512 + h * 128 + ch];
        const bf16_t* zf = Z + (size_t)(r0 + qq * 16) * INW + OFF_HFF + h * 128 + ch;
        const bf16_t* zb = Z + (size_t)(r0 + qq * 16) * INW + OFF_HFB + h * 128 + ch;
        const bf16_t* zv = Z + (size_t)(r0 + qq * 16) * INW + OFF_HI + h * 128 + ch;
        float kf[16], pf[16], lb_[16], kb[16], pb[16]; unsigned short vv[16];
        float runf = 0.f, runb = 0.f;
#pragma unroll
        for (int i = 0; i < 16; ++i) {
            { const float z = bf2f(zf[(size_t)i * INW]); const float e = __expf(-z), sg = frcp(1.f + e); kf[i] = (1.f - lbf) * e * sg; runf += __logf(lbf + (1.f - lbf) * sg); pf[i] = runf; }
            { const float z = bf2f(zb[(size_t)i * INW]); const float e = __expf(-z), sg = frcp(1.f + e); kb[i] = (1.f - lbb) * e * sg; lb_[i] = __logf(lbb + (1.f - lbb) * sg); runb += lb_[i]; pb[i] = runb; }
            vv[i] = zv[(size_t)i * INW]; }
        qtot[qq * 128 + ch] = runf; qtot[512 + qq * 128 + ch] = runb;
        __syncthreads();
        const float f0 = qtot[ch], f1 = qtot[128 + ch], f2 = qtot[256 + ch], f3 = qtot[384 + ch];
        const float b0 = qtot[512 + ch], b1 = qtot[640 + ch], b2 = qtot[768 + ch], b3 = qtot[896 + ch];
        const float totf = (f0 + f1) + (f2 + f3), totb = (b0 + b1) + (b2 + b3);
        const float beff = (qq > 0 ? f0 : 0.f) + (qq > 1 ? f1 : 0.f) + (qq > 2 ? f2 : 0.f);
        const float befb = (qq > 0 ? b0 : 0.f) + (qq > 1 ? b1 : 0.f) + (qq > 2 ? b2 : 0.f);
        unsigned pkf[8], pkb[8];
#pragma unroll
        for (int i = 0; i < 16; i += 2) {
            pkf[i >> 1] = cvt_pk(kf[i] * __expf(totf - (beff + pf[i])), kf[i + 1] * __expf(totf - (beff + pf[i + 1])));
            pkb[i >> 1] = cvt_pk(kb[i] * __expf(befb + pb[i] - lb_[i]), kb[i + 1] * __expf(befb + pb[i + 1] - lb_[i + 1])); }
        *(u32x4*)(Ktf + ch * 72 + qq * 16) = (u32x4){pkf[0], pkf[1], pkf[2], pkf[3]}; *(u32x4*)(Ktf + ch * 72 + qq * 16 + 8) = (u32x4){pkf[4], pkf[5], pkf[6], pkf[7]};
        *(u32x4*)(Ktb + ch * 72 + qq * 16) = (u32x4){pkb[0], pkb[1], pkb[2], pkb[3]}; *(u32x4*)(Ktb + ch * 72 + qq * 16 + 8) = (u32x4){pkb[4], pkb[5], pkb[6], pkb[7]};
        *(u32x4*)(Vt + ch * 72 + qq * 16) = (u32x4){vv[0] | ((unsigned)vv[1] << 16), vv[2] | ((unsigned)vv[3] << 16), vv[4] | ((unsigned)vv[5] << 16), vv[6] | ((unsigned)vv[7] << 16)};
        *(u32x4*)(Vt + ch * 72 + qq * 16 + 8) = (u32x4){vv[8] | ((unsigned)vv[9] << 16), vv[10] | ((unsigned)vv[11] << 16), vv[12] | ((unsigned)vv[13] << 16), vv[14] | ((unsigned)vv[15] << 16)};
        const int sidxf = ((seq * 4 + h) * 2 + 0) * nc + c, sidxb = ((seq * 4 + h) * 2 + 1) * nc + c;
        if (tid < 128) { DEC[(size_t)sidxf * 128 + tid] = __expf(totf); DEC[(size_t)sidxb * 128 + tid] = __expf(totb); }
        __syncthreads();
        const int ti = wid >> 1;
#pragma unroll
        for (int dir = 0; dir < 2; ++dir) { const bf16_t* Kt = dir ? Ktb : Ktf; bf16_t* Sb = ST + (size_t)(dir ? sidxb : sidxf) * 16384;
#pragma unroll
            for (int jj = 0; jj < 2; ++jj) { const int tj = 2 * (wid & 1) + jj; f32x16 acc = {};
#pragma unroll
                for (int s = 0; s < 4; ++s) { const bf16x8 X = *(const bf16x8*)(Kt + (32 * ti + r32) * 72 + 16 * s + 8 * hi); const bf16x8 Y = *(const bf16x8*)(Vt + (32 * tj + r32) * 72 + 16 * s + 8 * hi); acc = mfma32(X, Y, acc); }
#pragma unroll
                for (int rg = 0; rg < 4; ++rg) { u32x2 w; w.x = cvt_pk(acc[4 * rg], acc[4 * rg + 1]); w.y = cvt_pk(acc[4 * rg + 2], acc[4 * rg + 3]);
                    *(u32x2*)(Sb + (32 * tj + r32) * 128 + 32 * ti + 8 * rg + 4 * hi) = w; } } }
        __syncthreads();
    }
}
__device__ __forceinline__ void hg_scan(const int TIDX, const int BIDX, const int GDIM, bf16_t* ST, const float* DEC, int N) {
    const int nc = N / 64, nchains = (T / N) * 8; const int total = nchains * 8192;
    for (int idx = BIDX * 512 + TIDX; idx < total; idx += GDIM * 512) {
        const int chain = idx >> 13, e2 = idx & 8191, dir = chain & 1, cho = (e2 * 2) & 127;
        float s0 = 0.f, s1 = 0.f;
        for (int st = 0; st < nc; st += 8) {
            unsigned uu[8]; f32x2 dd[8];
#pragma unroll
            for (int k = 0; k < 8; ++k) { const int c = dir ? nc - 1 - (st + k) : st + k; const size_t si = (size_t)chain * nc + c;
                uu[k] = *(const unsigned*)(ST + si * 16384 + e2 * 2); dd[k] = *(const f32x2*)(DEC + si * 128 + cho); }
#pragma unroll
            for (int k = 0; k < 8; ++k) { const int c = dir ? nc - 1 - (st + k) : st + k; const size_t si = (size_t)chain * nc + c;
                *(unsigned*)(ST + si * 16384 + e2 * 2) = cvt_pk(s0, s1);
                s0 = dd[k][0] * s0 + bflo(uu[k]); s1 = dd[k][1] * s1 + bfhi(uu[k]); }
        }
    }
}
__device__ __forceinline__ void hg_pass3(const int TIDX, const int BIDX, const int GDIM, const bf16_t* Z, const bf16_t* ST, bf16_t* Y, const float* LBl, const float* onorm, int N, unsigned char* lds) {
    const int tid = TIDX, lane = tid & 63, wid = tid >> 6, r32 = lane & 31, hi = lane >> 5;
    const int ch = tid & 127, qq = tid >> 7, nc = N / 64;
    bf16_t* Qt = (bf16_t*)lds;
    bf16_t* Kt = (bf16_t*)(lds + 17408);
    bf16_t* Qh = (bf16_t*)(lds + 34816);
    bf16_t* Vt = (bf16_t*)(lds + 52224);
    float* qtot = (float*)(lds + 70656);
    float* ssq = (float*)(lds + 72704);
    const int dt = wid >> 1, jt = wid & 1;
    for (int u = BIDX; u < (T / 64) * 4; u += GDIM) {
        const int h = u & 3, cgl = u >> 2, seq = cgl / nc, c = cgl % nc, r0 = cgl * 64;
        f32x16 o = {};
        { const bf16_t* zv = Z + (size_t)(r0 + qq * 16) * INW + OFF_HI + h * 128 + ch; unsigned short vv[16];
#pragma unroll
            for (int i = 0; i < 16; ++i) vv[i] = zv[(size_t)i * INW];
            *(u32x4*)(Vt + ch * 72 + qq * 16) = (u32x4){vv[0] | ((unsigned)vv[1] << 16), vv[2] | ((unsigned)vv[3] << 16), vv[4] | ((unsigned)vv[5] << 16), vv[6] | ((unsigned)vv[7] << 16)};
            *(u32x4*)(Vt + ch * 72 + qq * 16 + 8) = (u32x4){vv[8] | ((unsigned)vv[9] << 16), vv[10] | ((unsigned)vv[11] << 16), vv[12] | ((unsigned)vv[13] << 16), vv[14] | ((unsigned)vv[15] << 16)}; }
#pragma unroll 1
        for (int dir = 0; dir < 2; ++dir) {
            const float lb = LBl[dir * 512 + h * 128 + ch];
            const bf16_t* zf = Z + (size_t)(r0 + qq * 16) * INW + (dir ? OFF_HFB : OFF_HFF) + h * 128 + ch;
            const bf16_t* zq = Z + (size_t)(r0 + qq * 16) * INW + OFF_HQ + h * 128 + ch;
            float lf[16], kk[16], pre[16], qv[16]; float run = 0.f;
#pragma unroll
            for (int i = 0; i < 16; ++i) { const float z = bf2f(zf[(size_t)i * INW]); const float e = __expf(-z), sg = frcp(1.f + e);
                lf[i] = __logf(lb + (1.f - lb) * sg); kk[i] = (1.f - lb) * e * sg; run += lf[i]; pre[i] = run; qv[i] = bf2f(zq[(size_t)i * INW]); }
            qtot[qq * 128 + ch] = run;
            __syncthreads();
            const float t0 = qtot[ch], t1 = qtot[128 + ch], t2 = qtot[256 + ch], t3 = qtot[384 + ch];
            const float before = (qq > 0 ? t0 : 0.f) + (qq > 1 ? t1 : 0.f) + (qq > 2 ? t2 : 0.f);
            const float after = (qq < 1 ? t1 : 0.f) + (qq < 2 ? t2 : 0.f) + (qq < 3 ? t3 : 0.f);
            const float ref = dir == 0 ? (t0 + t1) : (t2 + t3);
#pragma unroll
            for (int i = 0; i < 16; ++i) {
                const float cum = dir == 0 ? before + pre[i] : after + (run - pre[i] + lf[i]);
                const float d = cum - ref; const int p = qq * 16 + i;
                Qt[p * 136 + ch] = f2bf(qv[i] * __expf(d)); Kt[p * 136 + ch] = f2bf(kk[i] * __expf(-d)); Qh[p * 136 + ch] = f2bf(qv[i] * __expf(cum)); }
            __syncthreads();
            f32x16 a0 = {}, a1 = {};
#pragma unroll
            for (int s = 0; s < 8; ++s) { const bf16x8 Yq = *(const bf16x8*)(Qt + (32 * jt + r32) * 136 + 16 * s + 8 * hi);
                const bf16x8 X0 = *(const bf16x8*)(Kt + r32 * 136 + 16 * s + 8 * hi); const bf16x8 X1 = *(const bf16x8*)(Kt + (32 + r32) * 136 + 16 * s + 8 * hi);
                a0 = mfma32(X0, Yq, a0); a1 = mfma32(X1, Yq, a1); }
            const int j = 32 * jt + r32;
#pragma unroll
            for (int r = 0; r < 16; ++r) { const int l0 = crow(r, hi), l1 = 32 + l0;
                const bool k0 = dir == 0 ? (l0 <= j) : (l0 >= j), k1 = dir == 0 ? (l1 <= j) : (l1 >= j);
                a0[r] = k0 ? a0[r] : 0.f; a1[r] = k1 ? a1[r] : 0.f; }
            bf16x8 pa[2][2];
#pragma unroll
            for (int u2 = 0; u2 < 2; ++u2) { u32x4 w0, w1;
                w0.x = cvt_pk(a0[8 * u2], a0[8 * u2 + 1]); w0.y = cvt_pk(a0[8 * u2 + 2], a0[8 * u2 + 3]); w0.z = cvt_pk(a0[8 * u2 + 4], a0[8 * u2 + 5]); w0.w = cvt_pk(a0[8 * u2 + 6], a0[8 * u2 + 7]);
                w1.x = cvt_pk(a1[8 * u2], a1[8 * u2 + 1]); w1.y = cvt_pk(a1[8 * u2 + 2], a1[8 * u2 + 3]); w1.z = cvt_pk(a1[8 * u2 + 4], a1[8 * u2 + 5]); w1.w = cvt_pk(a1[8 * u2 + 6], a1[8 * u2 + 7]);
                pa[0][u2] = __builtin_bit_cast(bf16x8, w0); pa[1][u2] = __builtin_bit_cast(bf16x8, w1); }
#pragma unroll
            for (int lt = 0; lt < 2; ++lt)
#pragma unroll
                for (int u2 = 0; u2 < 2; ++u2) { const int base = 32 * lt + 16 * u2;
                    const s16x4 vlo = *(const s16x4*)(Vt + (32 * dt + r32) * 72 + base + 4 * hi); const s16x4 vhi = *(const s16x4*)(Vt + (32 * dt + r32) * 72 + base + 8 + 4 * hi);
                    const bf16x8 X = (bf16x8){vlo[0], vlo[1], vlo[2], vlo[3], vhi[0], vhi[1], vhi[2], vhi[3]};
                    o = mfma32(X, pa[lt][u2], o); }
            const int sidx = ((seq * 4 + h) * 2 + dir) * nc + c;
            const bf16_t* Sb = ST + (size_t)sidx * 16384 + (32 * dt + r32) * 128 + 8 * hi;
#pragma unroll
            for (int s = 0; s < 8; ++s) { const bf16x8 X = *(const bf16x8*)(Sb + 16 * s); const bf16x8 Yq = *(const bf16x8*)(Qh + (32 * jt + r32) * 136 + 16 * s + 8 * hi); o = mfma32(X, Yq, o); }
            __syncthreads();
        }
        float ss = 0.f;
#pragma unroll
        for (int r = 0; r < 16; ++r) ss += o[r] * o[r];
        ss += __shfl_xor(ss, 32);
        if (hi == 0) ssq[dt * 64 + 32 * jt + r32] = ss;
        __syncthreads();
        const int j = 32 * jt + r32;
        const float rinv = rsqrtf(((ssq[j] + ssq[64 + j]) + (ssq[128 + j] + ssq[192 + j])) * (1.f / 128.f) + EPS);
#pragma unroll
        for (int rg = 0; rg < 4; ++rg) { const int dv = 32 * dt + 8 * rg + 4 * hi;
            const u32x2 gw = *(const u32x2*)(Z + (size_t)(r0 + j) * INW + OFF_HG + h * 128 + dv); const f32x4 gn = *(const f32x4*)(onorm + dv);
            const float g0 = bflo(gw.x), g1 = bfhi(gw.x), g2 = bflo(gw.y), g3 = bfhi(gw.y);
            const float y0 = o[4 * rg] * rinv * gn[0] * g0 * sigm(g0), y1 = o[4 * rg + 1] * rinv * gn[1] * g1 * sigm(g1), y2 = o[4 * rg + 2] * rinv * gn[2] * g2 * sigm(g2), y3 = o[4 * rg + 3] * rinv * gn[3] * g3 * sigm(g3);
            u32x2 w; w.x = cvt_pk(y0, y1); w.y = cvt_pk(y2, y3);
            *(u32x2*)(Y + (size_t)(r0 + j) * YLD + 512 + h * 128 + dv) = w; }
        __syncthreads();
    }
}

#define ATT_PACK(P0, P1, PA) do { _Pragma("unroll") for (int u2 = 0; u2 < 2; ++u2) { u32x4 w0, w1; \
    w0.x = cvt_pk(P0[8 * u2], P0[8 * u2 + 1]); w0.y = cvt_pk(P0[8 * u2 + 2], P0[8 * u2 + 3]); w0.z = cvt_pk(P0[8 * u2 + 4], P0[8 * u2 + 5]); w0.w = cvt_pk(P0[8 * u2 + 6], P0[8 * u2 + 7]); \
    w1.x = cvt_pk(P1[8 * u2], P1[8 * u2 + 1]); w1.y = cvt_pk(P1[8 * u2 + 2], P1[8 * u2 + 3]); w1.z = cvt_pk(P1[8 * u2 + 4], P1[8 * u2 + 5]); w1.w = cvt_pk(P1[8 * u2 + 6], P1[8 * u2 + 7]); \
    PA[0][u2] = __builtin_bit_cast(bf16x8, w0); PA[1][u2] = __builtin_bit_cast(bf16x8, w1); } } while (0)
#define ATT_SOFTMAX(P0, P1, LR) do { \
    float ps = 0.f; _Pragma("unroll") for (int r = 0; r < 16; ++r) { P0[r] = __builtin_amdgcn_exp2f(P0[r]); P1[r] = __builtin_amdgcn_exp2f(P1[r]); ps += P0[r] + P1[r]; } \
    LR += ps; } while (0)
__device__ __forceinline__ void attn_phase(const int TIDX, const int BIDX, const int GDIM, const bf16_t* Z, const bf16_t* VT, bf16_t* Y, const float* gq, const float* gk, int N, unsigned char* lds) {
    const int tid = TIDX, lane = tid & 63, wid = tid >> 6, r32 = lane & 31, hi = lane >> 5;
    const int nq = N / 128, NT = N / 64;
    const int srow = tid >> 3, sch = tid & 7;
    float negshift;
    { float a = fabsf(gq[lane]), b = fabsf(gk[lane]);
#pragma unroll
      for (int o = 1; o < 64; o <<= 1) { a = fmaxf(a, __shfl_xor(a, o)); b = fmaxf(b, __shfl_xor(b, o)); }
      negshift = __uint_as_float(__builtin_amdgcn_readfirstlane(__float_as_uint(-fmaxf(11.5416f * a * b * 1.02f - 24.0f, 0.f)))); }
    const int vcu = (GDIM % 8 == 0) ? (BIDX % 8) * (GDIM / 8) + BIDX / 8 : BIDX;
    const int NU = (T / 128) * 4, upc = (NU + GDIM - 1) / GDIM;
    for (int ui = 0; ui < upc; ++ui) {
        const int u = vcu * upc + ui; if (u >= NU) break;
        const int qblk = u % nq, sk = u / nq, kvh = sk & 3, seq = sk >> 2;
        const int seqrow0 = seq * N;
        const int head = kvh * 4 + (wid >> 1); const int qrowA = seqrow0 + qblk * 128 + 64 * (wid & 1) + r32, qrowB = qrowA + 32;
        bf16x8 qa[4], qb[4];
        { const bf16_t* qp = Z + (size_t)qrowA * INW + OFF_AQ + head * 64 + hi * 8;
#pragma unroll
            for (int d0 = 0; d0 < 4; ++d0) { qa[d0] = *(const bf16x8*)(qp + d0 * 16); qb[d0] = *(const bf16x8*)(qp + (size_t)32 * INW + d0 * 16); } }
        const bf16_t* kg = Z + (size_t)(seqrow0 + srow) * INW + OFF_AK + kvh * 64 + sch * 8;
        const bf16_t* vg = VT + (size_t)((seq * 4 + kvh) * 64 + srow) * N + sch * 8;
        u32x4 kreg = *(const u32x4*)kg, vreg = *(const u32x4*)vg;
        *(u32x4*)(lds + srow * 144 + sch * 16) = kreg; *(u32x4*)(lds + 18432 + srow * 144 + sch * 16) = vreg;
        __syncthreads();
        float lA = 0.f, lB = 0.f; f32x16 oA0 = {}, oA1 = {}, oB0 = {}, oB1 = {};
        for (int t = 0; t < NT; ++t) {
            const int buf = t & 1;
            if (t + 1 < NT) { kreg = *(const u32x4*)(kg + (size_t)(t + 1) * 64 * INW); vreg = *(const u32x4*)(vg + (size_t)(t + 1) * 64); }
            const unsigned char* Ks = lds + buf * 9216; const unsigned char* Vs = lds + 18432 + buf * 9216;
            f32x16 pA0 = {}, pA1 = {}, pB0 = {}, pB1 = {};
#pragma unroll
            for (int d0 = 0; d0 < 4; ++d0) { const bf16x8 k0 = *(const bf16x8*)(Ks + r32 * 144 + (d0 * 16 + hi * 8) * 2); const bf16x8 k1 = *(const bf16x8*)(Ks + (32 + r32) * 144 + (d0 * 16 + hi * 8) * 2);
                pA0 = mfma32(k0, qa[d0], pA0); pA1 = mfma32(k1, qa[d0], pA1); pB0 = mfma32(k0, qb[d0], pB0); pB1 = mfma32(k1, qb[d0], pB1); }
            bf16x8 paA[2][2], paB[2][2];
            if (negshift != 0.f) {
#pragma unroll
                for (int r = 0; r < 16; ++r) { pA0[r] += negshift; pA1[r] += negshift; pB0[r] += negshift; pB1[r] += negshift; } }
            ATT_SOFTMAX(pA0, pA1, lA); ATT_PACK(pA0, pA1, paA);
            ATT_SOFTMAX(pB0, pB1, lB); ATT_PACK(pB0, pB1, paB);
#pragma unroll
            for (int hh = 0; hh < 2; ++hh)
#pragma unroll
                for (int u2 = 0; u2 < 2; ++u2) { const int base = 32 * hh + 16 * u2;
                    { const s16x4 vlo = *(const s16x4*)(Vs + r32 * 144 + (base + 4 * hi) * 2); const s16x4 vhi = *(const s16x4*)(Vs + r32 * 144 + (base + 8 + 4 * hi) * 2);
                      const bf16x8 vf = (bf16x8){vlo[0], vlo[1], vlo[2], vlo[3], vhi[0], vhi[1], vhi[2], vhi[3]};
                      oA0 = mfma32(vf, paA[hh][u2], oA0); oB0 = mfma32(vf, paB[hh][u2], oB0); }
                    { const s16x4 vlo = *(const s16x4*)(Vs + (32 + r32) * 144 + (base + 4 * hi) * 2); const s16x4 vhi = *(const s16x4*)(Vs + (32 + r32) * 144 + (base + 8 + 4 * hi) * 2);
                      const bf16x8 vf = (bf16x8){vlo[0], vlo[1], vlo[2], vlo[3], vhi[0], vhi[1], vhi[2], vhi[3]};
                      oA1 = mfma32(vf, paA[hh][u2], oA1); oB1 = mfma32(vf, paB[hh][u2], oB1); } }
            if (t + 1 < NT) { *(u32x4*)(lds + (buf ^ 1) * 9216 + srow * 144 + sch * 16) = kreg; *(u32x4*)(lds + 18432 + (buf ^ 1) * 9216 + srow * 144 + sch * 16) = vreg; }
            __syncthreads();
        }
        lA += __shfl_xor(lA, 32); lB += __shfl_xor(lB, 32);
        const float invA = 1.f / lA, invB = 1.f / lB;
        bf16_t* ypA = Y + (size_t)qrowA * YLD + 1024 + head * 64; bf16_t* ypB = ypA + (size_t)32 * YLD;
#pragma unroll
        for (int rg = 0; rg < 4; ++rg) { const int d = 8 * rg + 4 * hi; u32x2 w;
            w.x = cvt_pk(oA0[4 * rg] * invA, oA0[4 * rg + 1] * invA); w.y = cvt_pk(oA0[4 * rg + 2] * invA, oA0[4 * rg + 3] * invA); *(u32x2*)(ypA + d) = w;
            w.x = cvt_pk(oA1[4 * rg] * invA, oA1[4 * rg + 1] * invA); w.y = cvt_pk(oA1[4 * rg + 2] * invA, oA1[4 * rg + 3] * invA); *(u32x2*)(ypA + 32 + d) = w;
            w.x = cvt_pk(oB0[4 * rg] * invB, oB0[4 * rg + 1] * invB); w.y = cvt_pk(oB0[4 * rg + 2] * invB, oB0[4 * rg + 3] * invB); *(u32x2*)(ypB + d) = w;
            w.x = cvt_pk(oB1[4 * rg] * invB, oB1[4 * rg + 1] * invB); w.y = cvt_pk(oB1[4 * rg + 2] * invB, oB1[4 * rg + 3] * invB); *(u32x2*)(ypB + 32 + d) = w; }
    }
}

__device__ __forceinline__ float gelu_tanh(float a) { const float e = __builtin_amdgcn_exp2f(a * (2.3022081984f + 0.1029432396f * (a * a))); return a - a * frcp(e + 1.f);   }
__device__ __forceinline__ void unpack8(const u32x4 w, float* x) { x[0] = bflo(w.x); x[1] = bfhi(w.x); x[2] = bflo(w.y); x[3] = bfhi(w.y); x[4] = bflo(w.z); x[5] = bfhi(w.z); x[6] = bflo(w.w); x[7] = bfhi(w.w); }
__device__ __forceinline__ void conv_act(const int TIDX, const int BIDX, const int GDIM, const bf16_t* U, bf16_t* ACT, const float* cw, const float* cb, int N) {
    const int gthreads = GDIM * 512, gtid = BIDX * 512 + TIDX;
    constexpr int NCG = DFF / 8;
    for (int it = gtid; it < (T / 16) * NCG; it += gthreads) {
        const int cg8 = it % NCG, run = it / NCG, row0 = run * 16, t0 = row0 % N, c0 = cg8 * 8;
        float wa[3][8], wg[3][8], ba[8], bg[8];
#pragma unroll
        for (int k = 0; k < 3; ++k)
#pragma unroll
            for (int e = 0; e < 8; ++e) { wa[k][e] = cw[k * DFF2 + c0 + e]; wg[k][e] = cw[k * DFF2 + DFF + c0 + e]; }
#pragma unroll
        for (int e = 0; e < 8; ++e) { ba[e] = cb[c0 + e]; bg[e] = cb[DFF + c0 + e]; }
        float pa[8], pg[8], ca[8], cgv[8], na[8], ng[8];
        const u32x4 zero = (u32x4){0u, 0u, 0u, 0u};
        { const u32x4 a = t0 > 0 ? *(const u32x4*)(U + (size_t)(row0 - 1) * DFF2 + c0) : zero; const u32x4 g = t0 > 0 ? *(const u32x4*)(U + (size_t)(row0 - 1) * DFF2 + DFF + c0) : zero; unpack8(a, pa); unpack8(g, pg); }
        { const u32x4 a = *(const u32x4*)(U + (size_t)row0 * DFF2 + c0); const u32x4 g = *(const u32x4*)(U + (size_t)row0 * DFF2 + DFF + c0); unpack8(a, ca); unpack8(g, cgv); }
#pragma unroll 4
        for (int i = 0; i < 16; ++i) { const int row = row0 + i; const bool hasn = (t0 + i + 1) < N;
            const u32x4 a = hasn ? *(const u32x4*)(U + (size_t)(row + 1) * DFF2 + c0) : zero; const u32x4 g = hasn ? *(const u32x4*)(U + (size_t)(row + 1) * DFF2 + DFF + c0) : zero; unpack8(a, na); unpack8(g, ng);
            float r[8];
#pragma unroll
            for (int e = 0; e < 8; ++e) { const float av = pa[e] * wa[0][e] + ca[e] * wa[1][e] + na[e] * wa[2][e] + ba[e]; const float gv = pg[e] * wg[0][e] + cgv[e] * wg[1][e] + ng[e] * wg[2][e] + bg[e]; r[e] = gelu_tanh(av) * gv; }
            u32x4 o; o.x = cvt_pk(r[0], r[1]); o.y = cvt_pk(r[2], r[3]); o.z = cvt_pk(r[4], r[5]); o.w = cvt_pk(r[6], r[7]);
            *(u32x4*)(ACT + (size_t)row * DFF + c0) = o;
#pragma unroll
            for (int e = 0; e < 8; ++e) { pa[e] = ca[e]; pg[e] = cgv[e]; ca[e] = na[e]; cgv[e] = ng[e]; } }
    }
}


constexpr size_t WS_BAR = 256 * 1024;
#define XB_TMO      128
#define XB_XCNT(j)  (256  + 64 * (j))
#define XB_XSUB(j)  (1280 + 64 * (j))
#define XB_XGEN(j)  (2304 + 64 * (j))
#define XB_TOP      3328
#define XB_TOPGEN   3392
#define XCD_BAR_WORDS 3456
#define XB_SPIN_CAP (1u << 22)
__device__ __forceinline__ unsigned xb_ld(unsigned* p)              { return __hip_atomic_load(p, __ATOMIC_RELAXED, __HIP_MEMORY_SCOPE_AGENT); }
__device__ __forceinline__ unsigned xb_add(unsigned* p, unsigned v) { return __hip_atomic_fetch_add(p, v, __ATOMIC_RELAXED, __HIP_MEMORY_SCOPE_AGENT); }
__device__ __forceinline__ unsigned xb_xcc_id() { return (unsigned)__builtin_amdgcn_s_getreg((3 << 11) | 20) & 0xFu; }
#define XB_SPIN(cond, bar) do { unsigned _sp = 0; while (cond) { __builtin_amdgcn_s_sleep(1); \
    if ((++_sp & 255u) == 0u) { if (xb_ld(&(bar)[XB_TMO])) break; if (_sp > XB_SPIN_CAP) { atomicAdd(&(bar)[XB_TMO], 1u); break; } } } } while (0)
struct XcdBarrier { unsigned* bar; unsigned x; volatile LAS unsigned* st; };
__device__ __forceinline__ XcdBarrier xcd_barrier_post(unsigned* bar, volatile LAS unsigned* st) {
    XcdBarrier b; b.bar = bar; b.x = xb_xcc_id(); b.st = st;
    if (threadIdx.x == 0) (void)xb_add(&bar[XB_XCNT(b.x)], 1u);
    return b;
}
__device__ __forceinline__ void xcd_barrier_complete(unsigned* bar, unsigned x, unsigned& nloc, unsigned& nx) {
    const unsigned G = gridDim.x * gridDim.y * gridDim.z;
    unsigned sum, cnt, mine, sp = 0u;
    for (;;) {
        sum = 0u; cnt = 0u; mine = 0u;
#pragma unroll
        for (unsigned j = 0; j < 16; ++j) { const unsigned c = xb_ld(&bar[XB_XCNT(j)]); sum += c; cnt += (c > 0u) ? 1u : 0u; mine = (j == x) ? c : mine; }
        if (sum == G) break;
        __builtin_amdgcn_s_sleep(1);
        if ((++sp & 255u) == 0u) { if (xb_ld(&bar[XB_TMO])) break; if (sp > XB_SPIN_CAP) { atomicAdd(&bar[XB_TMO], 1u); break; } }
    }
    nloc = mine > 0u ? mine : 1u; nx = cnt > 0u ? cnt : 1u;
}
__device__ __forceinline__ void xcd_barrier(const XcdBarrier& b) {
    asm volatile("s_waitcnt vmcnt(0)" ::: "memory");
    __syncthreads();
    if (threadIdx.x == 0) {
        unsigned* bar = b.bar;
        __builtin_amdgcn_s_waitcnt(0);
        unsigned nloc = b.st[0], nx = b.st[1];
        if (nloc == 0u) { xcd_barrier_complete(bar, b.x, nloc, nx); b.st[0] = nloc; b.st[1] = nx; }
        const unsigned old = xb_add(&bar[XB_XSUB(b.x)], 1u);
        const unsigned gen = old / nloc;
        if (old + 1u == (gen + 1u) * nloc) {
            __builtin_amdgcn_fence(__ATOMIC_RELEASE, "agent");
            asm volatile("s_waitcnt vmcnt(0)" ::: "memory");
            const unsigned og = xb_add(&bar[XB_TOP], 1u);
            const unsigned tg = og / nx;
            if (og + 1u == (tg + 1u) * nx) xb_add(&bar[XB_TOPGEN], 1u);
            else XB_SPIN(xb_ld(&bar[XB_TOPGEN]) == tg, bar);
            __builtin_amdgcn_fence(__ATOMIC_ACQUIRE, "agent");
            xb_add(&bar[XB_XGEN(b.x)], 1u);
            asm volatile("s_waitcnt vmcnt(0)" ::: "memory");
        } else {
            XB_SPIN(xb_ld(&bar[XB_XGEN(b.x)]) == gen, bar);
            __builtin_amdgcn_fence(__ATOMIC_ACQUIRE, "agent");
            asm volatile("s_waitcnt vmcnt(0)" ::: "memory");
        }
    }
    __syncthreads();
}

__device__ __forceinline__ void conv_fix(const int TIDX, const int BIDX, const int GDIM, const bf16_t* EB, bf16_t* ACT, const float* cw, const float* cb, int N) {
    const int gthreads = GDIM * 512, gtid = BIDX * 512 + TIDX;
    constexpr int NCG = DFF / 8;
    for (int it = gtid; it < (T / 64) * 2 * NCG; it += gthreads) {
        const int cg8 = it % NCG, be = it / NCG, edge = be & 1, blk = be >> 1, c0 = cg8 * 8;
        const int row = blk * 64 + (edge ? 63 : 0), t = row % N;
        const bf16_t* pP = edge ? EB + ((size_t)blk * 4 + 2) * DFF2 : EB + ((size_t)(blk - 1) * 4 + 3) * DFF2;
        const bf16_t* pC = EB + ((size_t)blk * 4 + (edge ? 3 : 0)) * DFF2;
        const bf16_t* pN = edge ? EB + ((size_t)(blk + 1) * 4 + 0) * DFF2 : EB + ((size_t)blk * 4 + 1) * DFF2;
        const bool hasp = t > 0, hasn = t + 1 < N;
        const u32x4 zero = (u32x4){0u, 0u, 0u, 0u};
        float pa[8], pg[8], ca[8], cg[8], na[8], ng[8];
        unpack8(hasp ? *(const u32x4*)(pP + c0) : zero, pa); unpack8(hasp ? *(const u32x4*)(pP + DFF + c0) : zero, pg);
        unpack8(*(const u32x4*)(pC + c0), ca); unpack8(*(const u32x4*)(pC + DFF + c0), cg);
        unpack8(hasn ? *(const u32x4*)(pN + c0) : zero, na); unpack8(hasn ? *(const u32x4*)(pN + DFF + c0) : zero, ng);
        float r[8];
#pragma unroll
        for (int e = 0; e < 8; ++e) { const float av = pa[e] * cw[c0 + e] + ca[e] * cw[DFF2 + c0 + e] + na[e] * cw[2 * DFF2 + c0 + e] + cb[c0 + e];
            const float gv = pg[e] * cw[DFF + c0 + e] + cg[e] * cw[DFF2 + DFF + c0 + e] + ng[e] * cw[2 * DFF2 + DFF + c0 + e] + cb[DFF + c0 + e]; r[e] = gelu_tanh(av) * gv; }
        u32x4 o; o.x = cvt_pk(r[0], r[1]); o.y = cvt_pk(r[2], r[3]); o.z = cvt_pk(r[4], r[5]); o.w = cvt_pk(r[6], r[7]);
        *(u32x4*)(ACT + (size_t)row * DFF + c0) = o;
    }
}

constexpr int STEPS_PER_GROUP = 42, NSTEPS = 1 + NGROUP * STEPS_PER_GROUP;

__global__ void __launch_bounds__(512, 2) mega(Params P) {
    extern __shared__ __attribute__((aligned(16))) unsigned char lds[];
    LAS unsigned char* lds3 = (LAS unsigned char*)lds;
    typedef __attribute__((address_space(4))) const unsigned char* kaptr_t;
    const kaptr_t ka = (kaptr_t)__builtin_amdgcn_kernarg_segment_ptr();
#define KIN(i) (*(const float* const volatile __attribute__((address_space(4)))*)(ka + 8 * (i)))
#define KOUT (*(float* const volatile __attribute__((address_space(4)))*)(ka + 8 * 26))
#define KWS (*(unsigned char* const volatile __attribute__((address_space(4)))*)(ka + 8 * 27))
#define KLO (*(const volatile int __attribute__((address_space(4)))*)(ka + 8 * 28))
#define KHI (*(const volatile int __attribute__((address_space(4)))*)(ka + 8 * 28 + 4))
    const int step_hi = KHI;
    volatile LAS unsigned* MISC = (volatile LAS unsigned*)(lds3 + 131072 + 320);
    if (threadIdx.x < 32) MISC[threadIdx.x] = 0u;
    __syncthreads();
    XcdBarrier gbar = xcd_barrier_post((unsigned*)(KWS + WS_BAR), MISC + 8);
    bool first_sync = true;
    for (int step = KLO; step < step_hi; ++step) {
        unsigned char* ws = KWS;
        int tid_o = threadIdx.x, bx_o = blockIdx.x, G_o = gridDim.x;
        asm volatile("" : "+v"(tid_o)); asm volatile("" : "+s"(bx_o)); asm volatile("" : "+s"(G_o));
        const int G = G_o, bx = bx_o;
        if (step == 0) { phase0(tid_o, bx_o, G_o, ka, lds); }
        else {
            const int g = (step - 1) / STEPS_PER_GROUP, s = (step - 1) % STEPS_PER_GROUP;
            const int N = g == 0 ? 4096 : 8192;
            const float* xin = g == 0 ? KIN(0) : KIN(1) + (size_t)(g - 1) * T * DM;
            float* xout = KOUT + (size_t)g * T * DM;
            bf16_t* XB0 = (bf16_t*)(ws + WS_XB0); bf16_t* XB1 = (bf16_t*)(ws + WS_XB1);
            float* RSS0 = (float*)(ws + WS_RSS); float* RSS1 = RSS0 + (size_t)T * 16;
            bf16_t* Z = (bf16_t*)(ws + WS_Z); bf16_t* YC = (bf16_t*)(ws + WS_YCAT); bf16_t* MG = (bf16_t*)(ws + WS_MERGED);
            bf16_t* ST = (bf16_t*)(ws + WS_ST); bf16_t* FACC = (bf16_t*)(ws + WS_ST); bf16_t* VT = (bf16_t*)(ws + WS_VT); float* DEC = (float*)(ws + WS_DEC);
            bf16_t* ACT = YC; bf16_t* EB = (bf16_t*)(ws + WS_ST + 32 * MiB);
            if (s == 0) group_init(tid_o, bx_o, G_o, xin, XB0, RSS0);
            else if (s == 41) final_norm(tid_o, bx_o, G_o, xout, RSS0, KIN(25));
            else {
                const int layer = (s - 1) / 10, ls = (s - 1) % 10, cur = layer & 1;
                bf16_t* XBc = cur ? XB1 : XB0; bf16_t* XBn = cur ? XB0 : XB1;
                float* RSSc = cur ? RSS1 : RSS0; float* RSSn = cur ? RSS0 : RSS1;
                const float* LBl = (const float*)(ws + WS_LB) + layer * 1024;
                const float* xbase = layer == 0 ? xin : xout;
                if (ls == 0) {
                    pg8::Gemm gm{XBc, (const bf16_t*)(ws + WS_WIN) + (size_t)layer * INW * DM, XBLD, DM};
                    pg8::Sched<INW, 1, 0, 16, 0, 0, 0, 0> S{G, bx};
                    pg8::EpiScale E{Z, INW, RSSc, OFF_GATE / 256};
                    pg8::gemm_phase(tid_o, bx_o, G_o, lds3, gm, S, E);
                } else if (ls == 1) {
                    const float* pin = (g == 0 ? KIN(2) + (size_t)layer * 16384 * PLE : KIN(3) + (size_t)layer * 32768 * PLE + (size_t)(g - 1) * T * PLE);
                    prep_p(tid_o, bx_o, G_o, pin, XBc);
                    prep_qk(tid_o, bx_o, G_o, Z, (const f32x2*)(ws + WS_CS), KIN(11) + layer * 64, KIN(12) + layer * 64, N);
                    prep_vt(tid_o, bx_o, G_o, Z, VT, N, lds);
                    prep_pool(tid_o, bx_o, G_o, Z, YC, N);
                    hg_pass1(tid_o, bx_o, G_o, Z, ST, DEC, LBl, N, lds);
                } else if (ls == 2) {
                    hg_scan(tid_o, bx_o, G_o, ST, DEC, N);
                } else if (ls == 3) {
                    hg_pass3(tid_o, bx_o, G_o, Z, ST, YC, LBl, KIN(10) + layer * 128, N, lds);
                    attn_phase(tid_o, bx_o, G_o, Z, VT, YC, KIN(11) + layer * 64, KIN(12) + layer * 64, N, lds);
                } else if (ls == 4) {
                    pg8::Gemm gm{YC, (const bf16_t*)(ws + WS_WCAT) + (size_t)layer * DM * YLD, YLD, YLD};
                    pg8::Sched<DM, 3, 0, 8, 512, 8, 1024, 16> S{G, bx};
                    pg8::EpiMerge E{Z, FACC, MG};
                    pg8::gemm_phase(tid_o, bx_o, G_o, lds3, gm, S, E);
                } else if (ls == 5) {
                    pg8::Gemm gm{MG, (const bf16_t*)(ws + WS_WOUT) + (size_t)layer * DM * DM, DM, DM};
                    pg8::Sched<DM, 1, 0, 16, 0, 0, 0, 0> S{G, bx};
                    pg8::EpiX<0> E{XBc, xout, XBc, RSSn, nullptr, nullptr, 0};
                    pg8::gemm_phase(tid_o, bx_o, G_o, lds3, gm, S, E);
                } else if (ls == 6) {
                    pg8::Gemm gm{XBc, (const bf16_t*)(ws + WS_WUP) + (size_t)layer * DFF2 * DM, XBLD, DM};
                    pg8::Sched<DFF2, 1, 0, 16, 0, 0, 0, 0> S{G, bx};
                    pg8::EpiUp E{ws, layer, cur ^ 1};
                    pg8::gemm_phase(tid_o, bx_o, G_o, lds3, gm, S, E);
                } else if (ls == 7) {
                    conv_fix(tid_o, bx_o, G_o, EB, ACT, KIN(19) + (size_t)layer * 3 * DFF2, KIN(20) + (size_t)layer * DFF2, N);
                } else if (ls == 8) {
                    pg8::Gemm gm{ACT, (const bf16_t*)(ws + WS_WDOWN) + (size_t)layer * DM * DFF, DFF, DFF};
                    pg8::Sched<DM, 1, 0, 44, 0, 0, 0, 0> S{G, bx};
                    pg8::EpiX<0> E{XBc, xout, XBc, RSSc, nullptr, nullptr, 0};
                    pg8::gemm_phase(tid_o, bx_o, G_o, lds3, gm, S, E);
                } else {
                    pg8::Gemm gm{XBc, (const bf16_t*)(ws + WS_WPG) + (size_t)layer * DM * WPGLD, XBLD, WPGLD};
                    pg8::Sched<DM, 2, 1024, 4, 0, 16, 0, 0> S{G, bx};
                    pg8::EpiX<1> E{XBc, xout, XBn, RSSn, RSSc, FACC, layer == 3 ? 1 : 0};
                    pg8::gemm_phase(tid_o, bx_o, G_o, lds3, gm, S, E);
                }
            }
        }
        if (step + 1 < step_hi) { if (first_sync) { cg::this_grid().sync(); first_sync = false; } else xcd_barrier(gbar); }
    }
}


extern "C" void kernel_launch(void* const* d_in, const int* in_sizes, int n_in, void* d_out, int out_size, void* d_ws, size_t ws_size, hipStream_t stream) {
    static int grid = 0;
    if (grid == 0) {
        if (n_in != 26 || ws_size < WS_END) { fprintf(stderr, "kernel_launch: unexpected n_in %d or ws_size %zu (< %zu)\n", n_in, ws_size, (size_t)WS_END); grid = -1; return; }
        int dev = 0, cus = 0, per_cu = 0;
        hipGetDevice(&dev); hipDeviceGetAttribute(&cus, hipDeviceAttributeMultiprocessorCount, dev);
        hipFuncSetAttribute((const void*)mega, hipFuncAttributeMaxDynamicSharedMemorySize, LDS_BYTES);
        hipOccupancyMaxActiveBlocksPerMultiprocessor(&per_cu, (const void*)mega, 512, LDS_BYTES);
        (void)hipGetLastError();
        if (per_cu < 1) per_cu = 1;
        grid = cus * 1;
        fprintf(stderr, "kernel_launch: cus %d per_cu %d grid %d ws %zu\n", cus, per_cu, grid, ws_size);
    }
    if (grid < 0) return;
    Params p{};
    for (int i = 0; i < 26; ++i) p.in[i] = (const float*)d_in[i];
    p.out = (float*)d_out; p.ws = (unsigned char*)d_ws;
#if ONE_LAUNCH
    p.lo = 0; p.hi = NSTEPS;
    if (hipMemsetAsync((unsigned char*)d_ws + WS_BAR, 0, XCD_BAR_WORDS * 4, stream) != hipSuccess) fprintf(stderr, "memset failed\n");
    void* args[] = {&p};
    hipError_t e = hipLaunchCooperativeKernel((const void*)mega, dim3(grid), dim3(512), args, LDS_BYTES, stream);
    if (e != hipSuccess) fprintf(stderr, "cooperative launch failed: %s\n", hipGetErrorString(e));
#else
    for (int s = 0; s < NSTEPS; ++s) { p.lo = s; p.hi = s + 1; hipLaunchKernelGGL(mega, dim3(grid), dim3(512), LDS_BYTES, stream, p); }
#endif
}
```

```cpp
#include <hip/hip_runtime.h>
#include <hip/hip_cooperative_groups.h>
#include <cstdio>
#include <cstdint>
namespace cg = cooperative_groups;

#ifndef ONE_LAUNCH
#define ONE_LAUNCH 1
#endif

#define LAS __attribute__((address_space(3)))
typedef unsigned short bf16_t;
typedef short bf16x8 __attribute__((ext_vector_type(8)));
typedef short s16x4 __attribute__((ext_vector_type(4)));
typedef float f32x4 __attribute__((ext_vector_type(4)));
typedef float f32x2 __attribute__((ext_vector_type(2)));
typedef float f32x16 __attribute__((ext_vector_type(16)));
typedef unsigned u32x4 __attribute__((ext_vector_type(4)));
typedef unsigned u32x2 __attribute__((ext_vector_type(2)));

constexpr int DM = 1024, DEPTH = 4, PLE = 256, DFF = 2816, DFF2 = 5632;
constexpr int OFF_POOL = 0, OFF_HQ = 512, OFF_HFF = 1024, OFF_HFB = 1536, OFF_HI = 2048, OFF_HG = 2560, OFF_AQ = 3072, OFF_AK = 4096, OFF_AV = 4352, OFF_GATE = 4608, INW = 7680;
constexpr int T = 16384;
constexpr int NGROUP = 3;
constexpr float EPS = 1e-6f;
constexpr int XBLD = 1280;
constexpr int YLD = 2048;
constexpr int WPGLD = 1280;

constexpr size_t MiB = 1u << 20;
constexpr size_t WS_CS = 0;
constexpr size_t WS_LB = 64 * 1024;
constexpr size_t WS_WIN = 1 * MiB;
constexpr size_t WS_WCAT = 61 * MiB;
constexpr size_t WS_WOUT = 77 * MiB;
constexpr size_t WS_WUP = 85 * MiB;
constexpr size_t WS_WDOWN = 129 * MiB;
constexpr size_t WS_WPG = 151 * MiB;
constexpr size_t WS_XB0 = 161 * MiB;
constexpr size_t WS_XB1 = 201 * MiB;
constexpr size_t WS_RSS = 241 * MiB;
constexpr size_t WS_Z = 243 * MiB;
constexpr size_t WS_YCAT = 483 * MiB;
constexpr size_t WS_MERGED = 547 * MiB;
constexpr size_t WS_ST = 579 * MiB;
constexpr size_t WS_VT = 643 * MiB;
constexpr size_t WS_DEC = 651 * MiB;
constexpr size_t WS_END = 652 * MiB;

constexpr int LDS_BYTES = 153600;

typedef __bf16 bf16x2_t __attribute__((ext_vector_type(2)));
__device__ __forceinline__ unsigned cvt_pk(float lo, float hi) { f32x2 v = {lo, hi}; bf16x2_t b = __builtin_convertvector(v, bf16x2_t); return __builtin_bit_cast(unsigned, b); }
__device__ __forceinline__ float bf2f(bf16_t h) { return __uint_as_float((unsigned)h << 16); }
__device__ __forceinline__ float bflo(unsigned w) { return __uint_as_float(w << 16); }
__device__ __forceinline__ float bfhi(unsigned w) { return __uint_as_float(w & 0xffff0000u); }
__device__ __forceinline__ bf16_t f2bf(float f) { return (bf16_t)(cvt_pk(f, 0.f) & 0xffffu); }
__device__ __forceinline__ float frcp(float x) { return __builtin_amdgcn_rcpf(x); }
__device__ __forceinline__ float sigm(float x) { return frcp(1.f + __expf(-x)); }
__device__ __forceinline__ int crow(int r, int hi) { return (r & 3) + 8 * (r >> 2) + 4 * hi; }
__device__ __forceinline__ f32x16 mfma32(bf16x8 x, bf16x8 y, f32x16 c) { return __builtin_amdgcn_mfma_f32_32x32x16_bf16(x, y, c, 0, 0, 0); }
__device__ __forceinline__ float wave_sum(float v) {
#pragma unroll
    for (int o = 1; o < 64; o <<= 1) v += __shfl_xor(v, o);
    return v;
}

__device__ __forceinline__ float gelu_tanh_e(float a) { const float e = __builtin_amdgcn_exp2f(a * (2.3022081984f + 0.1029432396f * (a * a))); return a - a * frcp(e + 1.f);   }

constexpr size_t WS_RSS_OFF = 241u * 1048576u, WS_ACT_OFF = 483u * 1048576u, WS_EB_OFF = (579u + 32u) * 1048576u;
extern __shared__ __attribute__((aligned(16))) unsigned char g_lds[];
namespace pg8 {
constexpr int BM = 256, BK = 64, HALF = 128, HTB = HALF * BK * 2, STAGE_BYTES = 8 * HTB, NXCD = 8, WGM = 8;
__host__ __device__ __forceinline__ int lds_byte(int r, int c) { const int st = (r >> 4) * 2 + (c >> 5), rr = r & 15, cc = c & 31, ob = rr * 64 + cc * 2; return st * 1024 + (ob ^ (((ob >> 9) & 1) << 5)); }
__host__ __device__ __forceinline__ void stage_rc(int b, int& R, int& C) { const int st = b / 1024, sb = b % 1024, swz = sb ^ (((sb >> 9) & 1) << 5); R = (st >> 1) * 16 + swz / 64; C = (st & 1) * 32 + (swz % 64) / 2; }
__host__ __device__ __forceinline__ int perm32(int rho) { const int n = rho >> 4, i = rho & 15; return 8 * (i >> 2) + 4 * n + (i & 3); }

struct Unit { int pm, pn, br, koff, nt; };
struct Gemm { const bf16_t* A; const bf16_t* Bt; int lda, ldb; };

template <int N_, int NBR, int K0, int T0, int K1, int T1, int K2, int T2>
struct Sched {
    int G, c;
    static constexpr int nM = 16384 / BM, nN = N_ / BM, nwg = nM * nN;
    __device__ __forceinline__ bool next(int i, Unit& u) const {
        const int ti = i / NBR, br = i - ti * NBR;
        const int L = ti * G + c; if (L >= nwg) return false;
        int wgid = L; { constexpr int q = nwg / NXCD, r = nwg % NXCD; const int xcd = wgid % NXCD, off = wgid / NXCD; wgid = (xcd < r ? xcd * (q + 1) : r * (q + 1) + (xcd - r) * q) + off; }
        constexpr int nig = WGM * nN; const int gid = wgid / nig, fm = gid * WGM, gsz = (nM - fm) < WGM ? (nM - fm) : WGM;
        u.pm = fm + ((wgid % nig) % gsz); u.pn = (wgid % nig) / gsz; u.br = br;
        u.koff = br == 0 ? K0 : (br == 1 ? K1 : K2); u.nt = br == 0 ? T0 : (br == 1 ? T1 : T2);
        return true;
    }
};

template <class Epi, class SchedT>
__device__ __forceinline__ void gemm_phase(const int TIDX, const int BIDX, const int GDIM, LAS unsigned char* lds, const Gemm g, const SchedT& S, const Epi& E) {
    const int tid = TIDX, wid = __builtin_amdgcn_readfirstlane(tid >> 6), lane = tid & 63, wr = wid >> 2, wc = wid & 3, fr = lane & 15, fq = lane >> 4;
    unsigned voffA[2], voffB[2];
#pragma unroll
    for (int i = 0; i < 2; ++i) { int R, C; stage_rc(tid * 16 + i * 8192, R, C); const int Rb = (R & ~31) + perm32(R & 31);
        voffA[i] = (unsigned)(R * g.lda + C) * 2u; voffB[i] = (unsigned)(Rb * g.ldb + C) * 2u; }
    const size_t kstep = (size_t)(BK * 2);
    const size_t hstepA = (size_t)HALF * g.lda * 2, hstepB = (size_t)HALF * g.ldb * 2;
    const size_t tstepA = 2 * hstepA, tstepB = 2 * hstepB;
    const unsigned ldsw = (unsigned)wid * 1024u;
    const int aoff = lds_byte(wr * 64 + fr, fq * 8), boff = lds_byte(wc * 32 + fr, fq * 8);
#define PG8_SA(b, h) (((b) * 2 + (h)) * HTB)
#define PG8_SB(b, h) ((4 + (b) * 2 + (h)) * HTB)
#define PG8_STAGE(bufoff, gbase, voff) do { _Pragma("unroll") for (int _i = 0; _i < 2; ++_i) \
        __builtin_amdgcn_global_load_lds((const unsigned*)((const char*)(gbase) + (voff)[_i]), (LAS unsigned*)(lds + (bufoff) + ldsw + _i * 8192), 16, 0, 0); } while (0)
#define PG8_LDA(dst, b, h) do { _Pragma("unroll") for (int m = 0; m < 4; ++m) _Pragma("unroll") for (int k = 0; k < 2; ++k) dst[m][k] = *(const LAS bf16x8*)(lds + PG8_SA(b, h) + aoff + m * 2048 + k * 1024); } while (0)
#define PG8_LDB(dst, b, h) do { _Pragma("unroll") for (int n = 0; n < 2; ++n) _Pragma("unroll") for (int k = 0; k < 2; ++k) dst[n][k] = *(const LAS bf16x8*)(lds + PG8_SB(b, h) + boff + n * 2048 + k * 1024); } while (0)
#define PG8_MMA(ai, bj, At, Bt) do { __builtin_amdgcn_s_setprio(1); _Pragma("unroll") for (int m = 0; m < 4; ++m) _Pragma("unroll") for (int n = 0; n < 2; ++n) _Pragma("unroll") for (int k = 0; k < 2; ++k) \
        acc[ai][bj][m][n] = __builtin_amdgcn_mfma_f32_16x16x32_bf16(Bt[n][k], At[m][k], acc[ai][bj][m][n], 0, 0, 0); __builtin_amdgcn_s_setprio(0); } while (0)
#define PG8_WAIT_V(n) asm volatile("s_waitcnt vmcnt(" #n ")" ::: "memory")
#define PG8_WAIT_L(n) asm volatile("s_waitcnt lgkmcnt(" #n ")" ::: "memory")
#define PG8_BAR __builtin_amdgcn_s_barrier()
#define PG8_SCHED __builtin_amdgcn_sched_barrier(0)
    Unit cur, nxt; int ui = 0;
    if (!S.next(0, cur)) return;
    f32x4 acc[2][2][4][2];
#pragma unroll
    for (int a = 0; a < 2; ++a)
#pragma unroll
        for (int b = 0; b < 2; ++b)
#pragma unroll
            for (int m = 0; m < 4; ++m)
#pragma unroll
                for (int n = 0; n < 2; ++n) acc[a][b][m][n] = (f32x4){0.f, 0.f, 0.f, 0.f};
    bf16x8 At[4][2], B0[2][2], B1[2][2];
    const char* cA = (const char*)g.A + (size_t)cur.pm * tstepA + (size_t)cur.koff * 2; const char* cB = (const char*)g.Bt + (size_t)cur.pn * tstepB + (size_t)cur.koff * 2;
    PG8_STAGE(PG8_SB(0, 0), cB, voffB); PG8_STAGE(PG8_SB(0, 1), cB + hstepB, voffB); PG8_STAGE(PG8_SA(0, 0), cA, voffA); PG8_STAGE(PG8_SA(0, 1), cA + hstepA, voffA);
    if (wr == 1) PG8_BAR;
    PG8_WAIT_V(2); PG8_BAR;
    PG8_STAGE(PG8_SB(1, 0), cB + kstep, voffB); PG8_STAGE(PG8_SA(1, 0), cA + kstep, voffA); PG8_STAGE(PG8_SB(1, 1), cB + hstepB + kstep, voffB);
    PG8_WAIT_V(6); PG8_BAR;
    for (;;) {
        const bool has_next = S.next(ui + 1, nxt);
        const int nt = cur.nt;
        const char* nA = has_next ? (const char*)g.A + (size_t)nxt.pm * tstepA + (size_t)nxt.koff * 2 : cA; const char* nB = has_next ? (const char*)g.Bt + (size_t)nxt.pn * tstepB + (size_t)nxt.koff * 2 : cB;
        for (int t = 0; t < nt; t += 2) {
            const bool last = (t == nt - 2);
            const char* a1 = cA + (size_t)(t + 1) * kstep;
            const char* a2 = last ? nA : cA + (size_t)(t + 2) * kstep; const char* b2 = last ? nB : cB + (size_t)(t + 2) * kstep;
            const char* a3 = a2 + kstep; const char* b3 = b2 + kstep;
            PG8_LDB(B0, 0, 0); PG8_LDB(B1, 0, 1); PG8_SCHED; PG8_LDA(At, 0, 0); PG8_STAGE(PG8_SA(1, 1), a1 + hstepA, voffA);
            PG8_WAIT_V(8); PG8_WAIT_L(0); PG8_BAR; PG8_MMA(0, 0, At, B0); PG8_MMA(0, 1, At, B1); PG8_BAR; PG8_SCHED;
            PG8_LDA(At, 0, 1); PG8_STAGE(PG8_SB(0, 0), b2, voffB); PG8_STAGE(PG8_SB(0, 1), b2 + hstepB, voffB); PG8_STAGE(PG8_SA(0, 0), a2, voffA);
            PG8_WAIT_V(8); PG8_WAIT_L(0); PG8_BAR; PG8_MMA(1, 0, At, B0); PG8_MMA(1, 1, At, B1); PG8_BAR; PG8_SCHED;
            PG8_LDB(B0, 1, 0); PG8_LDB(B1, 1, 1); PG8_SCHED; PG8_LDA(At, 1, 0); PG8_STAGE(PG8_SA(0, 1), a2 + hstepA, voffA);
            PG8_WAIT_V(8); PG8_WAIT_L(0); PG8_BAR; PG8_MMA(0, 0, At, B0); PG8_MMA(0, 1, At, B1); PG8_BAR; PG8_SCHED;
            PG8_LDA(At, 1, 1); PG8_STAGE(PG8_SB(1, 0), b3, voffB); PG8_STAGE(PG8_SB(1, 1), b3 + hstepB, voffB); PG8_STAGE(PG8_SA(1, 0), a3, voffA);
            PG8_WAIT_V(8); PG8_WAIT_L(0); PG8_BAR; PG8_MMA(1, 0, At, B0); PG8_MMA(1, 1, At, B1); PG8_BAR; PG8_SCHED;
        }
        if (wr == 0) PG8_BAR;
        E(acc, cur, wr, wc, fr, fq);
        if (!has_next) break;
#pragma unroll
        for (int a = 0; a < 2; ++a)
#pragma unroll
            for (int b = 0; b < 2; ++b)
#pragma unroll
                for (int m = 0; m < 4; ++m)
#pragma unroll
                    for (int n = 0; n < 2; ++n) acc[a][b][m][n] = (f32x4){0.f, 0.f, 0.f, 0.f};
        cur = nxt; cA = nA; cB = nB; ++ui;
        if (wr == 1) PG8_BAR;
    }
    PG8_WAIT_V(0);
    PG8_BAR;
#undef PG8_SA
#undef PG8_SB
#undef PG8_STAGE
#undef PG8_LDA
#undef PG8_LDB
#undef PG8_MMA
#undef PG8_WAIT_V
#undef PG8_WAIT_L
#undef PG8_BAR
#undef PG8_SCHED
}

__device__ __forceinline__ float row_rinv(const float* rss, int row) {
    const f32x4* p = (const f32x4*)(rss + (size_t)row * 16);
    const f32x4 a = p[0], b = p[1], c = p[2], d = p[3];
    const float s = ((a[0] + a[1]) + (a[2] + a[3])) + ((b[0] + b[1]) + (b[2] + b[3])) + ((c[0] + c[1]) + (c[2] + c[3])) + ((d[0] + d[1]) + (d[2] + d[3]));
    return rsqrtf(s * (1.0f / DM) + EPS);
}
__device__ __forceinline__ float row_rinv_q(const float* rss, int row, int fq) {
    const f32x4 a = ((const f32x4*)(rss + (size_t)row * 16))[fq];
    float s = (a[0] + a[1]) + (a[2] + a[3]);
    s += __shfl_xor(s, 16); s += __shfl_xor(s, 32);
    return rsqrtf(s * (1.0f / DM) + EPS);
}
struct EpiScale {
    bf16_t* O; int ldc; const float* rss; int sig_pn;
    __device__ __forceinline__ void operator()(const f32x4 (&acc)[2][2][4][2], const Unit& u, int wr, int wc, int fr, int fq) const {
        const int col0 = u.pn * BM + wc * 32 + 8 * fq; const bool sg = u.pn >= sig_pn;
#pragma unroll
        for (int ai = 0; ai < 2; ++ai)
#pragma unroll
            for (int m = 0; m < 4; ++m) { const int row = u.pm * BM + ai * HALF + wr * 64 + m * 16 + fr; const float r = row_rinv(rss, row);
                bf16_t* rowp = O + (size_t)row * ldc + col0;
#pragma unroll
                for (int bj = 0; bj < 2; ++bj) { f32x4 v0 = acc[ai][bj][m][0] * r, v1 = acc[ai][bj][m][1] * r;
                    if (sg) {
#pragma unroll
                        for (int e = 0; e < 4; ++e) { v0[e] = sigm(v0[e]); v1[e] = sigm(v1[e]); } }
                    u32x4 w; w.x = cvt_pk(v0[0], v0[1]); w.y = cvt_pk(v0[2], v0[3]); w.z = cvt_pk(v1[0], v1[1]); w.w = cvt_pk(v1[2], v1[3]);
                    __builtin_nontemporal_store(w, (u32x4*)(rowp + bj * HALF)); }
                asm volatile("" ::: "memory"); }
    }
};
struct EpiMerge {
    const bf16_t* Z; bf16_t* facc; bf16_t* merged;
    __device__ __forceinline__ void operator()(const f32x4 (&acc)[2][2][4][2], const Unit& u, int wr, int wc, int fr, int fq) const {
        const int col0 = u.pn * BM + wc * 32 + 8 * fq;
#pragma unroll
        for (int ai = 0; ai < 2; ++ai)
#pragma unroll
            for (int m = 0; m < 4; ++m) { const int row = u.pm * BM + ai * HALF + wr * 64 + m * 16 + fr;
#pragma unroll
                for (int bj = 0; bj < 2; ++bj) { const int col = col0 + bj * HALF;
                    const u32x4 gw = *(const u32x4*)(Z + (size_t)row * INW + OFF_GATE + u.br * DM + col);
                    f32x4 v0 = acc[ai][bj][m][0], v1 = acc[ai][bj][m][1];
                    v0[0] *= bflo(gw.x); v0[1] *= bfhi(gw.x); v0[2] *= bflo(gw.y); v0[3] *= bfhi(gw.y);
                    v1[0] *= bflo(gw.z); v1[1] *= bfhi(gw.z); v1[2] *= bflo(gw.w); v1[3] *= bfhi(gw.w);
                    bf16_t* fp = facc + (size_t)row * DM + col;
                    if (u.br > 0) { const u32x4 pw = *(const u32x4*)fp; v0[0] += bflo(pw.x); v0[1] += bfhi(pw.x); v0[2] += bflo(pw.y); v0[3] += bfhi(pw.y); v1[0] += bflo(pw.z); v1[1] += bfhi(pw.z); v1[2] += bflo(pw.w); v1[3] += bfhi(pw.w); }
                    if (u.br < 2) { u32x4 w; w.x = cvt_pk(v0[0], v0[1]); w.y = cvt_pk(v0[2], v0[3]); w.z = cvt_pk(v1[0], v1[1]); w.w = cvt_pk(v1[2], v1[3]); *(u32x4*)fp = w; }
                    else { u32x4 w; w.x = cvt_pk(v0[0], v0[1]); w.y = cvt_pk(v0[2], v0[3]); w.z = cvt_pk(v1[0], v1[1]); w.w = cvt_pk(v1[2], v1[3]);
                        *(u32x4*)(merged + (size_t)row * DM + col) = w; } }
                asm volatile("" ::: "memory"); }
    }
};
template <int MODE> struct EpiX {
    const bf16_t* baseb; float* out; bf16_t* xb; float* rss_out; const float* rss_in; bf16_t* facc; int wout;
    __device__ __forceinline__ void operator()(const f32x4 (&acc)[2][2][4][2], const Unit& u, int wr, int wc, int fr, int fq) const {
        const int col0 = u.pn * BM + wc * 32 + 8 * fq;
#pragma unroll
        for (int ai = 0; ai < 2; ++ai)
#pragma unroll
            for (int m = 0; m < 4; ++m) { const int row = u.pm * BM + ai * HALF + wr * 64 + m * 16 + fr;
                if (MODE == 1 && u.br == 0) {
#pragma unroll
                    for (int bj = 0; bj < 2; ++bj) { bf16_t* fp = facc + (size_t)row * DM + col0 + bj * HALF; const f32x4 a0 = acc[ai][bj][m][0], a1 = acc[ai][bj][m][1]; u32x4 w; w.x = cvt_pk(a0[0], a0[1]); w.y = cvt_pk(a0[2], a0[3]); w.z = cvt_pk(a1[0], a1[1]); w.w = cvt_pk(a1[2], a1[3]); *(u32x4*)fp = w; }
                } else {
                    float r = 1.f; if (MODE == 1) r = row_rinv(rss_in, row);
                    float ss = 0.f;
#pragma unroll
                    for (int bj = 0; bj < 2; ++bj) { const int col = col0 + bj * HALF; const size_t off = (size_t)row * DM + col;
                        f32x4 v0 = acc[ai][bj][m][0], v1 = acc[ai][bj][m][1];
                        if (MODE == 1) { const u32x4 pw = *(const u32x4*)(facc + off); const f32x4 p0 = (f32x4){bflo(pw.x), bfhi(pw.x), bflo(pw.y), bfhi(pw.y)}, p1 = (f32x4){bflo(pw.z), bfhi(pw.z), bflo(pw.w), bfhi(pw.w)};
#pragma unroll
                            for (int e = 0; e < 4; ++e) { v0[e] = sigm(v0[e] * r) * p0[e]; v1[e] = sigm(v1[e] * r) * p1[e]; } }
                        const u32x4 bw = *(const u32x4*)(baseb + (size_t)row * XBLD + col);
                        v0[0] += bflo(bw.x); v0[1] += bfhi(bw.x); v0[2] += bflo(bw.y); v0[3] += bfhi(bw.y); v1[0] += bflo(bw.z); v1[1] += bfhi(bw.z); v1[2] += bflo(bw.w); v1[3] += bfhi(bw.w);
                        if (wout) { *(f32x4*)(out + off) = v0; *(f32x4*)(out + off + 4) = v1; }
                        ss += (v0[0] * v0[0] + v0[1] * v0[1]) + (v0[2] * v0[2] + v0[3] * v0[3]) + (v1[0] * v1[0] + v1[1] * v1[1]) + (v1[2] * v1[2] + v1[3] * v1[3]);
                        u32x4 w; w.x = cvt_pk(v0[0], v0[1]); w.y = cvt_pk(v0[2], v0[3]); w.z = cvt_pk(v1[0], v1[1]); w.w = cvt_pk(v1[2], v1[3]);
                        *(u32x4*)(xb + (size_t)row * XBLD + col) = w; }
                    ss += __shfl_xor(ss, 16); ss += __shfl_xor(ss, 32);
                    if (fq == 0) rss_out[(size_t)row * 16 + u.pn * 4 + wc] = ss;
                }
                asm volatile("" ::: "memory"); }
    }
};
#define PIN_ACC_HALF(A) asm volatile("" : "+v"(acc[A][0][0][0]), "+v"(acc[A][0][0][1]), "+v"(acc[A][0][1][0]), "+v"(acc[A][0][1][1]), "+v"(acc[A][0][2][0]), "+v"(acc[A][0][2][1]), "+v"(acc[A][0][3][0]), "+v"(acc[A][0][3][1]), \
    "+v"(acc[A][1][0][0]), "+v"(acc[A][1][0][1]), "+v"(acc[A][1][1][0]), "+v"(acc[A][1][1][1]), "+v"(acc[A][1][2][0]), "+v"(acc[A][1][2][1]), "+v"(acc[A][1][3][0]), "+v"(acc[A][1][3][1]))
#define PIN_ACC() do { PIN_ACC_HALF(0); PIN_ACC_HALF(1); } while (0)
struct EpiUp {
    unsigned char* ws; int layer, rsel;
    __device__ __forceinline__ void operator()(f32x4 (&acc)[2][2][4][2], const Unit& u, int wr, int wc, int fr, int fq) const {
        { const int lane_ = (int)__builtin_amdgcn_mbcnt_hi(~0u, __builtin_amdgcn_mbcnt_lo(~0u, 0u)); fr = lane_ & 15; fq = lane_ >> 4; }
        asm volatile("" : "+v"(fr), "+v"(fq));
        const unsigned row0 = (unsigned)(u.pm * BM + wr * 64 + fr);
        typedef __attribute__((address_space(4))) const unsigned char* kap_t; const kap_t ka_ = (kap_t)__builtin_amdgcn_kernarg_segment_ptr();
        const float* cw = *(const float* const volatile __attribute__((address_space(4)))*)(ka_ + 8 * 19) + (size_t)layer * 3 * DFF2;
        const float* cb = *(const float* const volatile __attribute__((address_space(4)))*)(ka_ + 8 * 20) + (size_t)layer * DFF2;
        unsigned char* ldsx = g_lds + 132096;
        const char* rssb = (const char*)(ws + WS_RSS_OFF + (size_t)rsel * (16384u * 64u)); char* actb = (char*)(ws + WS_ACT_OFF); char* ebb = (char*)(ws + WS_EB_OFF);
        {
            float* rtab = (float*)(g_lds + 148480 + (wr * 4 + wc) * 512);
            const unsigned lrow = (unsigned)(u.pm * BM + wr * 64) + (unsigned)(fq * 16 + fr);
            rtab[fq * 16 + fr] = row_rinv((const float*)rssb, (int)lrow); rtab[64 + fq * 16 + fr] = row_rinv((const float*)rssb, (int)(lrow + HALF));
            asm volatile("s_waitcnt lgkmcnt(0)" ::: "memory");
#pragma unroll
            for (int ai = 0; ai < 2; ++ai)
#pragma unroll
                for (int m = 0; m < 4; ++m) { const float r = rtab[ai * 64 + m * 16 + fr];
#pragma unroll
                    for (int bj = 0; bj < 2; ++bj) { acc[ai][bj][m][0] *= r; acc[ai][bj][m][1] *= r; } } }
        PIN_ACC();
        unsigned char* sl = ldsx + (wr * 4 + wc) * 2048 + fr * 32 + fq * 8;
#pragma unroll
        for (int n = 0; n < 2; ++n) {
            const unsigned ch = (unsigned)(u.pn * 128 + wc * 32 + 8 * fq + 4 * n);
#pragma unroll
            for (int bj = 0; bj < 2; ++bj) {
                const char* cwb = (const char*)cw; const unsigned coff = (bj * DFF + ch) * 4u;
                const f32x4 w0 = *(const f32x4*)(cwb + coff), w1 = *(const f32x4*)(cwb + coff + DFF2 * 4u), w2 = *(const f32x4*)(cwb + coff + 2u * DFF2 * 4u), bb = *(const f32x4*)((const char*)cb + coff);
#pragma unroll
                for (int ai = 0; ai < 2; ++ai) {
                    const unsigned blk = (unsigned)(u.pm * 4 + ai * 2 + wr);
                    u32x2 pk[4];
#pragma unroll
                    for (int m = 0; m < 4; ++m) { const f32x4 x = acc[ai][bj][m][n]; pk[m].x = cvt_pk(x[0], x[1]); pk[m].y = cvt_pk(x[2], x[3]); *(u32x2*)(sl + m * 512) = pk[m]; }
                    { const unsigned dummy = 256u * 4u * DFF2 * 2u + (unsigned)(fq * 16 + fr) * 8u;
                      const unsigned e0 = fr < 2 ? ((blk * 4u + (unsigned)fr) * DFF2 + bj * DFF + ch) * 2u : dummy, e3 = fr >= 14 ? ((blk * 4u + (unsigned)(fr - 12)) * DFF2 + bj * DFF + ch) * 2u : dummy;
                      *(u32x2*)(ebb + e0) = pk[0]; *(u32x2*)(ebb + e3) = pk[3]; }
                    asm volatile("s_waitcnt lgkmcnt(0)" ::: "memory");
#pragma unroll
                    for (int m = 0; m < 4; ++m) { const f32x4 x = acc[ai][bj][m][n];
                        const u32x2 pw = *(const u32x2*)(sl + m * 512 - 32), nw = *(const u32x2*)(sl + m * 512 + 32);
                        const f32x4 pv = (f32x4){bflo(pw.x), bfhi(pw.x), bflo(pw.y), bfhi(pw.y)}, nv = (f32x4){bflo(nw.x), bfhi(nw.x), bflo(nw.y), bfhi(nw.y)};
                        acc[ai][bj][m][n] = pv * w0 + x * w1 + nv * w2 + bb; }
                    asm volatile("s_waitcnt lgkmcnt(0)" ::: "memory");
                    PIN_ACC();
                }
            }
        }
        {
            const unsigned ch0 = (unsigned)(u.pn * 128 + wc * 32 + 8 * fq);
#pragma unroll
            for (int ai = 0; ai < 2; ++ai)
#pragma unroll
                for (int m = 0; m < 4; ++m) { const unsigned row = row0 + ai * HALF + m * 16;
                    const f32x4 ca0 = acc[ai][0][m][0], cg0 = acc[ai][1][m][0], ca1 = acc[ai][0][m][1], cg1 = acc[ai][1][m][1];
                    u32x4 w;
                    w.x = cvt_pk(gelu_tanh_e(ca0[0]) * cg0[0], gelu_tanh_e(ca0[1]) * cg0[1]); w.y = cvt_pk(gelu_tanh_e(ca0[2]) * cg0[2], gelu_tanh_e(ca0[3]) * cg0[3]);
                    w.z = cvt_pk(gelu_tanh_e(ca1[0]) * cg1[0], gelu_tanh_e(ca1[1]) * cg1[1]); w.w = cvt_pk(gelu_tanh_e(ca1[2]) * cg1[2], gelu_tanh_e(ca1[3]) * cg1[3]);
                    __builtin_nontemporal_store(w, (u32x4*)(actb + (row * DFF + ch0) * 2u)); }
        }
    }
};
}

struct Params { const float* in[26]; float* out; unsigned char* ws; int lo, hi; };

__device__ __forceinline__ void transpose_item(const float* W, int K, int N, bf16_t* WT, int ldwt, int kdst, const float* gk, float sc_lo, int nlo, int nhi, float* scr, int item, int lane, bool permup = false) {
    const int nblk = N / 32, kb = item / nblk, nb = item % nblk, k0 = 64 * kb, n0 = 32 * nb;
    const float sc = (n0 >= nlo && n0 < nhi) ? sc_lo : 1.f;
#pragma unroll 8
    for (int i = 0; i < 32; ++i) { const int kk = 2 * i + (lane >> 5); float g = gk ? gk[k0 + kk] : 1.f; scr[kk * 33 + (lane & 31)] = W[(size_t)(k0 + kk) * N + n0 + (lane & 31)] * g * sc; }
    asm volatile("s_waitcnt lgkmcnt(0)" ::: "memory");
    const int c = lane & 7;
    int drow0 = n0; if (permup) { const int isg = n0 >= DFF ? 1 : 0, chn = n0 - isg * DFF; drow0 = (chn >> 7) * 256 + isg * 128 + (chn & 127); }
#pragma unroll
    for (int j = 0; j < 4; ++j) { const int n = (lane >> 3) + 8 * j; const float* s = scr + (8 * c) * 33 + n;
        u32x4 o; o.x = cvt_pk(s[0 * 33], s[1 * 33]); o.y = cvt_pk(s[2 * 33], s[3 * 33]); o.z = cvt_pk(s[4 * 33], s[5 * 33]); o.w = cvt_pk(s[6 * 33], s[7 * 33]);
        *(u32x4*)(WT + (size_t)(drow0 + n) * ldwt + kdst + k0 + 8 * c) = o; }
    asm volatile("s_waitcnt lgkmcnt(0)" ::: "memory");
}

typedef __attribute__((address_space(4))) const unsigned char* kaptr_t;
#define KIN0(i) (*(const float* const volatile __attribute__((address_space(4)))*)(ka + 8 * (i)))
__device__ __forceinline__ void phase0(const int TIDX, const int BIDX, const int GDIM, kaptr_t ka, unsigned char* lds) {
    const int tid = TIDX, lane = tid & 63, wave = tid >> 6;
    unsigned char* ws = *(unsigned char* const volatile __attribute__((address_space(4)))*)(ka + 8 * 27);
    const int gthreads = GDIM * 512, gtid = BIDX * 512 + tid;
    if (gtid < 128 * 16) { const int p = gtid >> 4, i = gtid & 15; const float invf = exp2f(-(float)i * (13.287712379549449f / 16.0f)); const float ang = (float)p * invf;
        ((f32x2*)(ws + WS_CS))[gtid] = (f32x2){cosf(ang), sinf(ang)}; }
    if (gtid >= 2048 && gtid < 2048 + 1024) { const int q = gtid - 2048, dir = q >> 9, ch = q & 511; const float* raw = KIN0(dir ? 9 : 8);
        float v[4], mx = -1e30f;
#pragma unroll
        for (int l = 0; l < 4; ++l) { v[l] = raw[l * 512 + ch]; mx = fmaxf(mx, v[l]); }
        float s = 0.f;
#pragma unroll
        for (int l = 0; l < 4; ++l) { v[l] = expf(v[l] - mx); s += v[l]; }
        float run = 0.f; float* LB = (float*)(ws + WS_LB);
#pragma unroll
        for (int l = 0; l < 4; ++l) { if (l > 0) run += v[l] / s; LB[(l * 2 + dir) * 512 + ch] = run; } }
    float* scr = (float*)(lds + wave * 16384);
    const int gw = BIDX * 8 + wave, NGW = GDIM * 8;
    constexpr int I_IN = 16 * 240, I_UP = 16 * 176, I_DN = 44 * 32, I_HG = 8 * 32, I_AT = 16 * 32, I_OUT = 16 * 32, I_PG = 16 * 32, I_PL = 4 * 32;
    constexpr int PER_L = I_IN + I_UP + I_DN + I_HG + I_AT + I_OUT + I_PG + I_PL;
    for (int it = gw; it < 4 * PER_L; it += NGW) {
        const int l = it / PER_L; int r = it % PER_L;
        if (r < I_IN) { transpose_item(KIN0(5) + (size_t)l * DM * INW, DM, INW, (bf16_t*)(ws + WS_WIN) + (size_t)l * INW * DM, DM, 0, KIN0(4) + l * DM, 0.08838834764831845f, OFF_HQ, OFF_HFF, scr, r, lane); continue; } r -= I_IN;
        if (r < I_UP) { transpose_item(KIN0(18) + (size_t)l * DM * DFF2, DM, DFF2, (bf16_t*)(ws + WS_WUP) + (size_t)l * DFF2 * DM, DM, 0, KIN0(17) + l * DM, 1.f, 0, 0, scr, r, lane, true); continue; } r -= I_UP;
        if (r < I_DN) { transpose_item(KIN0(21) + (size_t)l * DFF * DM, DFF, DM, (bf16_t*)(ws + WS_WDOWN) + (size_t)l * DM * DFF, DFF, 0, nullptr, 1.f, 0, 0, scr, r, lane); continue; } r -= I_DN;
        if (r < I_HG) { transpose_item(KIN0(14) + (size_t)l * 512 * DM, 512, DM, (bf16_t*)(ws + WS_WCAT) + (size_t)l * DM * YLD, YLD, 512, nullptr, 1.f, 0, 0, scr, r, lane); continue; } r -= I_HG;
        if (r < I_AT) { transpose_item(KIN0(15) + (size_t)l * DM * DM, DM, DM, (bf16_t*)(ws + WS_WCAT) + (size_t)l * DM * YLD, YLD, 1024, nullptr, 1.f, 0, 0, scr, r, lane); continue; } r -= I_AT;
        if (r < I_OUT) { transpose_item(KIN0(16) + (size_t)l * DM * DM, DM, DM, (bf16_t*)(ws + WS_WOUT) + (size_t)l * DM * DM, DM, 0, nullptr, 1.f, 0, 0, scr, r, lane); continue; } r -= I_OUT;
        if (r < I_PG) { transpose_item(KIN0(23) + (size_t)l * DM * DM, DM, DM, (bf16_t*)(ws + WS_WPG) + (size_t)l * DM * WPGLD, WPGLD, 0, KIN0(22) + l * DM, 1.f, 0, 0, scr, r, lane); continue; } r -= I_PG;
        transpose_item(KIN0(24) + (size_t)l * PLE * DM, PLE, DM, (bf16_t*)(ws + WS_WPG) + (size_t)l * DM * WPGLD, WPGLD, 1024, nullptr, 1.f, 0, 0, scr, r, lane);
    }
    for (int o = gtid; o < 4 * 512 * 1024; o += gthreads) {
        const int n = o & 1023, gc = (o >> 10) & 511, l = o >> 19, g = gc >> 7;
        const float* pw = KIN0(6) + ((size_t)l * 512 + gc) * 128; const float* sc = KIN0(7) + l * 512 + g * 128; const float* wb = KIN0(13) + ((size_t)l * 512 + g * 128) * DM + n;
        float s = 0.f;
#pragma unroll 8
        for (int d = 0; d < 128; ++d) s += pw[d] * sc[d] * wb[(size_t)d * DM];
        ((bf16_t*)(ws + WS_WCAT))[((size_t)l * DM + n) * YLD + gc] = f2bf(s);
    }
}

__device__ __forceinline__ void group_init(const int TIDX, const int BIDX, const int GDIM, const float* xin, bf16_t* xb, float* rss) {
    const int lane = TIDX & 63; const int gw = BIDX * 8 + (TIDX >> 6), NGW = GDIM * 8;
    for (int row = gw; row < T; row += NGW) {
        const f32x4* xr = (const f32x4*)(xin + (size_t)row * DM) + lane; float s = 0.f;
        f32x4 v[4];
#pragma unroll
        for (int j = 0; j < 4; ++j) { v[j] = xr[64 * j]; s += (v[j][0] * v[j][0] + v[j][1] * v[j][1]) + (v[j][2] * v[j][2] + v[j][3] * v[j][3]); }
        s = wave_sum(s);
#pragma unroll
        for (int j = 0; j < 4; ++j) { u32x2 w; w.x = cvt_pk(v[j][0], v[j][1]); w.y = cvt_pk(v[j][2], v[j][3]); *(u32x2*)(xb + (size_t)row * XBLD + 4 * lane + 256 * j) = w; }
        if (lane < 16) rss[(size_t)row * 16 + lane] = lane == 0 ? s : 0.f;
    }
}
__device__ __forceinline__ void final_norm(const int TIDX, const int BIDX, const int GDIM, float* out, const float* rss, const float* gfin) {
    const int lane = TIDX & 63; const int gw = BIDX * 8 + (TIDX >> 6), NGW = GDIM * 8;
    for (int row = gw; row < T; row += NGW) {
        const float r = pg8::row_rinv(rss, row);
        f32x4* xr = (f32x4*)(out + (size_t)row * DM) + lane; const f32x4* gp = (const f32x4*)gfin + lane;
#pragma unroll
        for (int j = 0; j < 4; ++j) { f32x4 v = xr[64 * j]; const f32x4 g = gp[64 * j]; v = v * r * g;
            xr[64 * j] = v; }
    }
}

__device__ __forceinline__ void prep_p(const int TIDX, const int BIDX, const int GDIM, const float* pin, bf16_t* xb) {
    const int lane = TIDX & 63; const int gw = BIDX * 8 + (TIDX >> 6), NGW = GDIM * 8;
    for (int row = gw; row < T; row += NGW) { const f32x4 v = ((const f32x4*)(pin + (size_t)row * PLE))[lane];
        u32x2 w; w.x = cvt_pk(v[0], v[1]); w.y = cvt_pk(v[2], v[3]); *(u32x2*)(xb + (size_t)row * XBLD + 1024 + 4 * lane) = w; }
}
__device__ __forceinline__ void prep_qk(const int TIDX, const int BIDX, const int GDIM, bf16_t* Z, const f32x2* cs, const float* gq, const float* gk, int N) {
    const int gthreads = GDIM * 512, gtid = BIDX * 512 + TIDX;
    for (int it = gtid; it < T * 40; it += gthreads) {
        const int a = it & 1, hv = (it >> 1) % 20, row = (it >> 1) / 20;
        const bool isq = hv < 16; const int coloff = isq ? OFF_AQ + hv * 64 : OFF_AK + (hv - 16) * 64;
        bf16_t* p = Z + (size_t)row * INW + coloff + a * 32;
        u32x4 w[4];
#pragma unroll
        for (int j = 0; j < 4; ++j) w[j] = ((const u32x4*)p)[j];
        float x[32];
#pragma unroll
        for (int j = 0; j < 4; ++j) { x[8 * j + 0] = bflo(w[j].x); x[8 * j + 1] = bfhi(w[j].x); x[8 * j + 2] = bflo(w[j].y); x[8 * j + 3] = bfhi(w[j].y);
            x[8 * j + 4] = bflo(w[j].z); x[8 * j + 5] = bfhi(w[j].z); x[8 * j + 6] = bflo(w[j].w); x[8 * j + 7] = bfhi(w[j].w); }
        float ss = 0.f;
#pragma unroll
        for (int d = 0; d < 32; ++d) ss += x[d] * x[d];
        ss += __shfl_xor(ss, 1);
        float r = rsqrtf(ss * (1.f / 64.f) + EPS); if (isq) r *= 0.125f * 1.4426950408889634f;
        const float* g = (isq ? gq : gk) + a * 32;
        const int t = row % N; const int pos = a == 0 ? (t >> 6) : (t & 63);
        const f32x2* c = cs + pos * 16;
        float y[32];
#pragma unroll
        for (int i = 0; i < 16; ++i) { const f32x2 cc = c[i]; const float x1 = x[i] * g[i], x2 = x[16 + i] * g[16 + i];
            y[i] = (x1 * cc.x - x2 * cc.y) * r; y[16 + i] = (x2 * cc.x + x1 * cc.y) * r; }
#pragma unroll
        for (int j = 0; j < 4; ++j) { u32x4 o; o.x = cvt_pk(y[8 * j], y[8 * j + 1]); o.y = cvt_pk(y[8 * j + 2], y[8 * j + 3]); o.z = cvt_pk(y[8 * j + 4], y[8 * j + 5]); o.w = cvt_pk(y[8 * j + 6], y[8 * j + 7]);
            ((u32x4*)p)[j] = o; }
    }
}
__device__ __forceinline__ void prep_vt(const int TIDX, const int BIDX, const int GDIM, const bf16_t* Z, bf16_t* VT, int N, unsigned char* lds) {
    const int tid = TIDX; bf16_t* Ts = (bf16_t*)lds;
    const int nc = N / 64;
    for (int it = BIDX; it < (T / 64) * 4; it += GDIM) {
        const int kvh = it & 3, cgl = it >> 2, seq = cgl / nc, c = cgl % nc;
        { const int t = tid >> 3, ch = tid & 7; const u32x4 v = *(const u32x4*)(Z + (size_t)(cgl * 64 + t) * INW + OFF_AV + kvh * 64 + ch * 8); *(u32x4*)(Ts + t * 72 + ch * 8) = v; }
        __syncthreads();
        { const int d = tid >> 3, ch = tid & 7; unsigned short e[8];
#pragma unroll
            for (int i = 0; i < 8; ++i) e[i] = Ts[(ch * 8 + i) * 72 + d];
            u32x4 o; o.x = e[0] | ((unsigned)e[1] << 16); o.y = e[2] | ((unsigned)e[3] << 16); o.z = e[4] | ((unsigned)e[5] << 16); o.w = e[6] | ((unsigned)e[7] << 16);
            *(u32x4*)(VT + (size_t)((seq * 4 + kvh) * 64 + d) * N + c * 64 + ch * 8) = o; }
        __syncthreads();
    }
}
template <int HALFW> __device__ __forceinline__ void pool_item(const bf16_t* Z, bf16_t* Y, int N, int row, int c8) {
    const int t = row % N;
    float s[8];
#pragma unroll
    for (int e = 0; e < 8; ++e) s[e] = 0.f;
    u32x4 w[2 * HALFW];
#pragma unroll
    for (int k = 0; k < 2 * HALFW; ++k) { const int q = t - HALFW + k; const bool ok = q >= 0 && q < N;
        w[k] = ok ? *(const u32x4*)(Z + (size_t)(row - HALFW + k) * INW + OFF_POOL + c8) : (u32x4){0u, 0u, 0u, 0u}; }
#pragma unroll
    for (int k = 0; k < 2 * HALFW; ++k) { s[0] += bflo(w[k].x); s[1] += bfhi(w[k].x); s[2] += bflo(w[k].y); s[3] += bfhi(w[k].y); s[4] += bflo(w[k].z); s[5] += bfhi(w[k].z); s[6] += bflo(w[k].w); s[7] += bfhi(w[k].w); }
    const int lo = t - HALFW < 0 ? 0 : t - HALFW, hi = t + HALFW > N ? N : t + HALFW;
    const float ic = frcp((float)(hi - lo));
    const u32x4 c = w[HALFW];
    const float u[8] = {bflo(c.x), bfhi(c.x), bflo(c.y), bfhi(c.y), bflo(c.z), bfhi(c.z), bflo(c.w), bfhi(c.w)};
    u32x4 o; o.x = cvt_pk(s[0] * ic - u[0], s[1] * ic - u[1]); o.y = cvt_pk(s[2] * ic - u[2], s[3] * ic - u[3]); o.z = cvt_pk(s[4] * ic - u[4], s[5] * ic - u[5]); o.w = cvt_pk(s[6] * ic - u[6], s[7] * ic - u[7]);
    *(u32x4*)(Y + (size_t)row * YLD + c8) = o;
}
__device__ __forceinline__ void prep_pool(const int TIDX, const int BIDX, const int GDIM, const bf16_t* Z, bf16_t* Y, int N) {
    const int gthreads = GDIM * 512, gtid = BIDX * 512 + TIDX;
    for (int it = gtid; it < T * 64; it += gthreads) {
        const int g = it / (T * 16), rem = it % (T * 16), row = rem >> 4, c8 = g * 128 + (rem & 15) * 8;
        if (g == 0) pool_item<1>(Z, Y, N, row, c8); else if (g == 1) pool_item<2>(Z, Y, N, row, c8); else if (g == 2) pool_item<4>(Z, Y, N, row, c8); else pool_item<8>(Z, Y, N, row, c8);
    }
}

__device__ __forceinline__ void hg_pass1(const int TIDX, const int BIDX, const int GDIM, const bf16_t* Z, bf16_t* ST, float* DEC, const float* LBl  , int N, unsigned char* lds) {
    const int tid = TIDX, lane = tid & 63, wid = tid >> 6, r32 = lane & 31, hi = lane >> 5;
    const int ch = tid & 127, qq = tid >> 7, nc = N / 64;
    bf16_t* Ktf = (bf16_t*)lds;
    bf16_t* Ktb = (bf16_t*)(lds + 18432);
    bf16_t* Vt = (bf16_t*)(lds + 36864);
    float* qtot = (float*)(lds + 55296);
    for (int u = BIDX; u < (T / 64) * 4; u += GDIM) {
        const int h = u & 3, cgl = u >> 2, seq = cgl / nc, c = cgl % nc, r0 = cgl * 64;
        const float lbf = LBl[h * 128 + ch], lbb = LBl[512 + h * 128 + ch];
        const bf16_t* zf = Z + (size_t)(r0 + qq * 16) * INW + OFF_HFF + h * 128 + ch;
        const bf16_t* zb = Z + (size_t)(r0 + qq * 16) * INW + OFF_HFB + h * 128 + ch;
        const bf16_t* zv = Z + (size_t)(r0 + qq * 16) * INW + OFF_HI + h * 128 + ch;
        float kf[16], pf[16], lb_[16], kb[16], pb[16]; unsigned short vv[16];
        float runf = 0.f, runb = 0.f;
#pragma unroll
        for (int i = 0; i < 16; ++i) {
            { const float z = bf2f(zf[(size_t)i * INW]); const float e = __expf(-z), sg = frcp(1.f + e); kf[i] = (1.f - lbf) * e * sg; runf += __logf(lbf + (1.f - lbf) * sg); pf[i] = runf; }
            { const float z = bf2f(zb[(size_t)i * INW]); const float e = __expf(-z), sg = frcp(1.f + e); kb[i] = (1.f - lbb) * e * sg; lb_[i] = __logf(lbb + (1.f - lbb) * sg); runb += lb_[i]; pb[i] = runb; }
            vv[i] = zv[(size_t)i * INW]; }
        qtot[qq * 128 + ch] = runf; qtot[512 + qq * 128 + ch] = runb;
        __syncthreads();
        const float f0 = qtot[ch], f1 = qtot[128 + ch], f2 = qtot[256 + ch], f3 = qtot[384 + ch];
        const float b0 = qtot[512 + ch], b1 = qtot[640 + ch], b2 = qtot[768 + ch], b3 = qtot[896 + ch];
        const float totf = (f0 + f1) + (f2 + f3), totb = (b0 + b1) + (b2 + b3);
        const float beff = (qq > 0 ? f0 : 0.f) + (qq > 1 ? f1 : 0.f) + (qq > 2 ? f2 : 0.f);
        const float befb = (qq > 0 ? b0 : 0.f) + (qq > 1 ? b1 : 0.f) + (qq > 2 ? b2 : 0.f);
        unsigned pkf[8], pkb[8];
#pragma unroll
        for (int i = 0; i < 16; i += 2) {
            pkf[i >> 1] = cvt_pk(kf[i] * __expf(totf - (beff + pf[i])), kf[i + 1] * __expf(totf - (beff + pf[i + 1])));
            pkb[i >> 1] = cvt_pk(kb[i] * __expf(befb + pb[i] - lb_[i]), kb[i + 1] * __expf(befb + pb[i + 1] - lb_[i + 1])); }
        *(u32x4*)(Ktf + ch * 72 + qq * 16) = (u32x4){pkf[0], pkf[1], pkf[2], pkf[3]}; *(u32x4*)(Ktf + ch * 72 + qq * 16 + 8) = (u32x4){pkf[4], pkf[5], pkf[6], pkf[7]};
        *(u32x4*)(Ktb + ch * 72 + qq * 16) = (u32x4){pkb[0], pkb[1], pkb[2], pkb[3]}; *(u32x4*)(Ktb + ch * 72 + qq * 16 + 8) = (u32x4){pkb[4], pkb[5], pkb[6], pkb[7]};
        *(u32x4*)(Vt + ch * 72 + qq * 16) = (u32x4){vv[0] | ((unsigned)vv[1] << 16), vv[2] | ((unsigned)vv[3] << 16), vv[4] | ((unsigned)vv[5] << 16), vv[6] | ((unsigned)vv[7] << 16)};
        *(u32x4*)(Vt + ch * 72 + qq * 16 + 8) = (u32x4){vv[8] | ((unsigned)vv[9] << 16), vv[10] | ((unsigned)vv[11] << 16), vv[12] | ((unsigned)vv[13] << 16), vv[14] | ((unsigned)vv[15] << 16)};
        const int sidxf = ((seq * 4 + h) * 2 + 0) * nc + c, sidxb = ((seq * 4 + h) * 2 + 1) * nc + c;
        if (tid < 128) { DEC[(size_t)sidxf * 128 + tid] = __expf(totf); DEC[(size_t)sidxb * 128 + tid] = __expf(totb); }
        __syncthreads();
        const int ti = wid >> 1;
#pragma unroll
        for (int dir = 0; dir < 2; ++dir) { const bf16_t* Kt = dir ? Ktb : Ktf; bf16_t* Sb = ST + (size_t)(dir ? sidxb : sidxf) * 16384;
#pragma unroll
            for (int jj = 0; jj < 2; ++jj) { const int tj = 2 * (wid & 1) + jj; f32x16 acc = {};
#pragma unroll
                for (int s = 0; s < 4; ++s) { const bf16x8 X = *(const bf16x8*)(Kt + (32 * ti + r32) * 72 + 16 * s + 8 * hi); const bf16x8 Y = *(const bf16x8*)(Vt + (32 * tj + r32) * 72 + 16 * s + 8 * hi); acc = mfma32(X, Y, acc); }
#pragma unroll
                for (int rg = 0; rg < 4; ++rg) { u32x2 w; w.x = cvt_pk(acc[4 * rg], acc[4 * rg + 1]); w.y = cvt_pk(acc[4 * rg + 2], acc[4 * rg + 3]);
                    *(u32x2*)(Sb + (32 * tj + r32) * 128 + 32 * ti + 8 * rg + 4 * hi) = w; } } }
        __syncthreads();
    }
}
__device__ __forceinline__ void hg_scan(const int TIDX, const int BIDX, const int GDIM, bf16_t* ST, const float* DEC, int N) {
    const int nc = N / 64, nchains = (T / N) * 8; const int total = nchains * 8192;
    for (int idx = BIDX * 512 + TIDX; idx < total; idx += GDIM * 512) {
        const int chain = idx >> 13, e2 = idx & 8191, dir = chain & 1, cho = (e2 * 2) & 127;
        float s0 = 0.f, s1 = 0.f;
        for (int st = 0; st < nc; st += 8) {
            unsigned uu[8]; f32x2 dd[8];
#pragma unroll
            for (int k = 0; k < 8; ++k) { const int c = dir ? nc - 1 - (st + k) : st + k; const size_t si = (size_t)chain * nc + c;
                uu[k] = *(const unsigned*)(ST + si * 16384 + e2 * 2); dd[k] = *(const f32x2*)(DEC + si * 128 + cho); }
#pragma unroll
            for (int k = 0; k < 8; ++k) { const int c = dir ? nc - 1 - (st + k) : st + k; const size_t si = (size_t)chain * nc + c;
                *(unsigned*)(ST + si * 16384 + e2 * 2) = cvt_pk(s0, s1);
                s0 = dd[k][0] * s0 + bflo(uu[k]); s1 = dd[k][1] * s1 + bfhi(uu[k]); }
        }
    }
}
__device__ __forceinline__ void hg_pass3(const int TIDX, const int BIDX, const int GDIM, const bf16_t* Z, const bf16_t* ST, bf16_t* Y, const float* LBl, const float* onorm, int N, unsigned char* lds) {
    const int tid = TIDX, lane = tid & 63, wid = tid >> 6, r32 = lane & 31, hi = lane >> 5;
    const int ch = tid & 127, qq = tid >> 7, nc = N / 64;
    bf16_t* Qt = (bf16_t*)lds;
    bf16_t* Kt = (bf16_t*)(lds + 17408);
    bf16_t* Qh = (bf16_t*)(lds + 34816);
    bf16_t* Vt = (bf16_t*)(lds + 52224);
    float* qtot = (float*)(lds + 70656);
    float* ssq = (float*)(lds + 72704);
    const int dt = wid >> 1, jt = wid & 1;
    for (int u = BIDX; u < (T / 64) * 4; u += GDIM) {
        const int h = u & 3, cgl = u >> 2, seq = cgl / nc, c = cgl % nc, r0 = cgl * 64;
        f32x16 o = {};
        { const bf16_t* zv = Z + (size_t)(r0 + qq * 16) * INW + OFF_HI + h * 128 + ch; unsigned short vv[16];
#pragma unroll
            for (int i = 0; i < 16; ++i) vv[i] = zv[(size_t)i * INW];
            *(u32x4*)(Vt + ch * 72 + qq * 16) = (u32x4){vv[0] | ((unsigned)vv[1] << 16), vv[2] | ((unsigned)vv[3] << 16), vv[4] | ((unsigned)vv[5] << 16), vv[6] | ((unsigned)vv[7] << 16)};
            *(u32x4*)(Vt + ch * 72 + qq * 16 + 8) = (u32x4){vv[8] | ((unsigned)vv[9] << 16), vv[10] | ((unsigned)vv[11] << 16), vv[12] | ((unsigned)vv[13] << 16), vv[14] | ((unsigned)vv[15] << 16)}; }
#pragma unroll 1
        for (int dir = 0; dir < 2; ++dir) {
            const float lb = LBl[dir * 512 + h * 128 + ch];
            const bf16_t* zf = Z + (size_t)(r0 + qq * 16) * INW + (dir ? OFF_HFB : OFF_HFF) + h * 128 + ch;
            const bf16_t* zq = Z + (size_t)(r0 + qq * 16) * INW + OFF_HQ + h * 128 + ch;
            float lf[16], kk[16], pre[16], qv[16]; float run = 0.f;
#pragma unroll
            for (int i = 0; i < 16; ++i) { const float z = bf2f(zf[(size_t)i * INW]); const float e = __expf(-z), sg = frcp(1.f + e);
                lf[i] = __logf(lb + (1.f - lb) * sg); kk[i] = (1.f - lb) * e * sg; run += lf[i]; pre[i] = run; qv[i] = bf2f(zq[(size_t)i * INW]); }
            qtot[qq * 128 + ch] = run;
            __syncthreads();
            const float t0 = qtot[ch], t1 = qtot[128 + ch], t2 = qtot[256 + ch], t3 = qtot[384 + ch];
            const float before = (qq > 0 ? t0 : 0.f) + (qq > 1 ? t1 : 0.f) + (qq > 2 ? t2 : 0.f);
            const float after = (qq < 1 ? t1 : 0.f) + (qq < 2 ? t2 : 0.f) + (qq < 3 ? t3 : 0.f);
            const float ref = dir == 0 ? (t0 + t1) : (t2 + t3);
#pragma unroll
            for (int i = 0; i < 16; ++i) {
                const float cum = dir == 0 ? before + pre[i] : after + (run - pre[i] + lf[i]);
                const float d = cum - ref; const int p = qq * 16 + i;
                Qt[p * 136 + ch] = f2bf(qv[i] * __expf(d)); Kt[p * 136 + ch] = f2bf(kk[i] * __expf(-d)); Qh[p * 136 + ch] = f2bf(qv[i] * __expf(cum)); }
            __syncthreads();
            f32x16 a0 = {}, a1 = {};
#pragma unroll
            for (int s = 0; s < 8; ++s) { const bf16x8 Yq = *(const bf16x8*)(Qt + (32 * jt + r32) * 136 + 16 * s + 8 * hi);
                const bf16x8 X0 = *(const bf16x8*)(Kt + r32 * 136 + 16 * s + 8 * hi); const bf16x8 X1 = *(const bf16x8*)(Kt + (32 + r32) * 136 + 16 * s + 8 * hi);
                a0 = mfma32(X0, Yq, a0); a1 = mfma32(X1, Yq, a1); }
            const int j = 32 * jt + r32;
#pragma unroll
            for (int r = 0; r < 16; ++r) { const int l0 = crow(r, hi), l1 = 32 + l0;
                const bool k0 = dir == 0 ? (l0 <= j) : (l0 >= j), k1 = dir == 0 ? (l1 <= j) : (l1 >= j);
                a0[r] = k0 ? a0[r] : 0.f; a1[r] = k1 ? a1[r] : 0.f; }
            bf16x8 pa[2][2];
#pragma unroll
            for (int u2 = 0; u2 < 2; ++u2) { u32x4 w0, w1;
                w0.x = cvt_pk(a0[8 * u2], a0[8 * u2 + 1]); w0.y = cvt_pk(a0[8 * u2 + 2], a0[8 * u2 + 3]); w0.z = cvt_pk(a0[8 * u2 + 4], a0[8 * u2 + 5]); w0.w = cvt_pk(a0[8 * u2 + 6], a0[8 * u2 + 7]);
                w1.x = cvt_pk(a1[8 * u2], a1[8 * u2 + 1]); w1.y = cvt_pk(a1[8 * u2 + 2], a1[8 * u2 + 3]); w1.z = cvt_pk(a1[8 * u2 + 4], a1[8 * u2 + 5]); w1.w = cvt_pk(a1[8 * u2 + 6], a1[8 * u2 + 7]);
                pa[0][u2] = __builtin_bit_cast(bf16x8, w0); pa[1][u2] = __builtin_bit_cast(bf16x8, w1); }
#pragma unroll
            for (int lt = 0; lt < 2; ++lt)
#pragma unroll
                for (int u2 = 0; u2 < 2; ++u2) { const int base = 32 * lt + 16 * u2;
                    const s16x4 vlo = *(const s16x4*)(Vt + (32 * dt + r32) * 72 + base + 4 * hi); const s16x4 vhi = *(const s16x4*)(Vt + (32 * dt + r32) * 72 + base + 8 + 4 * hi);
                    const bf16x8 X = (bf16x8){vlo[0], vlo[1], vlo[2], vlo[3], vhi[0], vhi[1], vhi[2], vhi[3]};
                    o = mfma32(X, pa[lt][u2], o); }
            const int sidx = ((seq * 4 + h) * 2 + dir) * nc + c;
            const bf16_t* Sb = ST + (size_t)sidx * 16384 + (32 * dt + r32) * 128 + 8 * hi;
#pragma unroll
            for (int s = 0; s < 8; ++s) { const bf16x8 X = *(const bf16x8*)(Sb + 16 * s); const bf16x8 Yq = *(const bf16x8*)(Qh + (32 * jt + r32) * 136 + 16 * s + 8 * hi); o = mfma32(X, Yq, o); }
            __syncthreads();
        }
        float ss = 0.f;
#pragma unroll
        for (int r = 0; r < 16; ++r) ss += o[r] * o[r];
        ss += __shfl_xor(ss, 32);
        if (hi == 0) ssq[dt * 64 + 32 * jt + r32] = ss;
        __syncthreads();
        const int j = 32 * jt + r32;
        const float rinv = rsqrtf(((ssq[j] + ssq[64 + j]) + (ssq[128 + j] + ssq[192 + j])) * (1.f / 128.f) + EPS);
#pragma unroll
        for (int rg = 0; rg < 4; ++rg) { const int dv = 32 * dt + 8 * rg + 4 * hi;
            const u32x2 gw = *(const u32x2*)(Z + (size_t)(r0 + j) * INW + OFF_HG + h * 128 + dv); const f32x4 gn = *(const f32x4*)(onorm + dv);
            const float g0 = bflo(gw.x), g1 = bfhi(gw.x), g2 = bflo(gw.y), g3 = bfhi(gw.y);
            const float y0 = o[4 * rg] * rinv * gn[0] * g0 * sigm(g0), y1 = o[4 * rg + 1] * rinv * gn[1] * g1 * sigm(g1), y2 = o[4 * rg + 2] * rinv * gn[2] * g2 * sigm(g2), y3 = o[4 * rg + 3] * rinv * gn[3] * g3 * sigm(g3);
            u32x2 w; w.x = cvt_pk(y0, y1); w.y = cvt_pk(y2, y3);
            *(u32x2*)(Y + (size_t)(r0 + j) * YLD + 512 + h * 128 + dv) = w; }
        __syncthreads();
    }
}

#define ATT_PACK(P0, P1, PA) do { _Pragma("unroll") for (int u2 = 0; u2 < 2; ++u2) { u32x4 w0, w1; \
    w0.x = cvt_pk(P0[8 * u2], P0[8 * u2 + 1]); w0.y = cvt_pk(P0[8 * u2 + 2], P0[8 * u2 + 3]); w0.z = cvt_pk(P0[8 * u2 + 4], P0[8 * u2 + 5]); w0.w = cvt_pk(P0[8 * u2 + 6], P0[8 * u2 + 7]); \
    w1.x = cvt_pk(P1[8 * u2], P1[8 * u2 + 1]); w1.y = cvt_pk(P1[8 * u2 + 2], P1[8 * u2 + 3]); w1.z = cvt_pk(P1[8 * u2 + 4], P1[8 * u2 + 5]); w1.w = cvt_pk(P1[8 * u2 + 6], P1[8 * u2 + 7]); \
    PA[0][u2] = __builtin_bit_cast(bf16x8, w0); PA[1][u2] = __builtin_bit_cast(bf16x8, w1); } } while (0)
#define ATT_SOFTMAX(P0, P1, LR) do { \
    float ps = 0.f; _Pragma("unroll") for (int r = 0; r < 16; ++r) { P0[r] = __builtin_amdgcn_exp2f(P0[r]); P1[r] = __builtin_amdgcn_exp2f(P1[r]); ps += P0[r] + P1[r]; } \
    LR += ps; } while (0)
__device__ __forceinline__ void attn_phase(const int TIDX, const int BIDX, const int GDIM, const bf16_t* Z, const bf16_t* VT, bf16_t* Y, const float* gq, const float* gk, int N, unsigned char* lds) {
    const int tid = TIDX, lane = tid & 63, wid = tid >> 6, r32 = lane & 31, hi = lane >> 5;
    const int nq = N / 128, NT = N / 64;
    const int srow = tid >> 3, sch = tid & 7;
    float negshift;
    { float a = fabsf(gq[lane]), b = fabsf(gk[lane]);
#pragma unroll
      for (int o = 1; o < 64; o <<= 1) { a = fmaxf(a, __shfl_xor(a, o)); b = fmaxf(b, __shfl_xor(b, o)); }
      negshift = __uint_as_float(__builtin_amdgcn_readfirstlane(__float_as_uint(-fmaxf(11.5416f * a * b * 1.02f - 24.0f, 0.f)))); }
    const int vcu = (GDIM % 8 == 0) ? (BIDX % 8) * (GDIM / 8) + BIDX / 8 : BIDX;
    const int NU = (T / 128) * 4, upc = (NU + GDIM - 1) / GDIM;
    for (int ui = 0; ui < upc; ++ui) {
        const int u = vcu * upc + ui; if (u >= NU) break;
        const int qblk = u % nq, sk = u / nq, kvh = sk & 3, seq = sk >> 2;
        const int seqrow0 = seq * N;
        const int head = kvh * 4 + (wid >> 1); const int qrowA = seqrow0 + qblk * 128 + 64 * (wid & 1) + r32, qrowB = qrowA + 32;
        bf16x8 qa[4], qb[4];
        { const bf16_t* qp = Z + (size_t)qrowA * INW + OFF_AQ + head * 64 + hi * 8;
#pragma unroll
            for (int d0 = 0; d0 < 4; ++d0) { qa[d0] = *(const bf16x8*)(qp + d0 * 16); qb[d0] = *(const bf16x8*)(qp + (size_t)32 * INW + d0 * 16); } }
        const bf16_t* kg = Z + (size_t)(seqrow0 + srow) * INW + OFF_AK + kvh * 64 + sch * 8;
        const bf16_t* vg = VT + (size_t)((seq * 4 + kvh) * 64 + srow) * N + sch * 8;
        u32x4 kreg = *(const u32x4*)kg, vreg = *(const u32x4*)vg;
        *(u32x4*)(lds + srow * 144 + sch * 16) = kreg; *(u32x4*)(lds + 18432 + srow * 144 + sch * 16) = vreg;
        __syncthreads();
        float lA = 0.f, lB = 0.f; f32x16 oA0 = {}, oA1 = {}, oB0 = {}, oB1 = {};
        for (int t = 0; t < NT; ++t) {
            const int buf = t & 1;
            if (t + 1 < NT) { kreg = *(const u32x4*)(kg + (size_t)(t + 1) * 64 * INW); vreg = *(const u32x4*)(vg + (size_t)(t + 1) * 64); }
            const unsigned char* Ks = lds + buf * 9216; const unsigned char* Vs = lds + 18432 + buf * 9216;
            f32x16 pA0 = {}, pA1 = {}, pB0 = {}, pB1 = {};
#pragma unroll
            for (int d0 = 0; d0 < 4; ++d0) { const bf16x8 k0 = *(const bf16x8*)(Ks + r32 * 144 + (d0 * 16 + hi * 8) * 2); const bf16x8 k1 = *(const bf16x8*)(Ks + (32 + r32) * 144 + (d0 * 16 + hi * 8) * 2);
                pA0 = mfma32(k0, qa[d0], pA0); pA1 = mfma32(k1, qa[d0], pA1); pB0 = mfma32(k0, qb[d0], pB0); pB1 = mfma32(k1, qb[d0], pB1); }
            bf16x8 paA[2][2], paB[2][2];
            if (negshift != 0.f) {
#pragma unroll
                for (int r = 0; r < 16; ++r) { pA0[r] += negshift; pA1[r] += negshift; pB0[r] += negshift; pB1[r] += negshift; } }
            ATT_SOFTMAX(pA0, pA1, lA); ATT_PACK(pA0, pA1, paA);
            ATT_SOFTMAX(pB0, pB1, lB); ATT_PACK(pB0, pB1, paB);
#pragma unroll
            for (int hh = 0; hh < 2; ++hh)
#pragma unroll
                for (int u2 = 0; u2 < 2; ++u2) { const int base = 32 * hh + 16 * u2;
                    { const s16x4 vlo = *(const s16x4*)(Vs + r32 * 144 + (base + 4 * hi) * 2); const s16x4 vhi = *(const s16x4*)(Vs + r32 * 144 + (base + 8 + 4 * hi) * 2);
                      const bf16x8 vf = (bf16x8){vlo[0], vlo[1], vlo[2], vlo[3], vhi[0], vhi[1], vhi[2], vhi[3]};
                      oA0 = mfma32(vf, paA[hh][u2], oA0); oB0 = mfma32(vf, paB[hh][u2], oB0); }
                    { const s16x4 vlo = *(const s16x4*)(Vs + (32 + r32) * 144 + (base + 4 * hi) * 2); const s16x4 vhi = *(const s16x4*)(Vs + (32 + r32) * 144 + (base + 8 + 4 * hi) * 2);
                      const bf16x8 vf = (bf16x8){vlo[0], vlo[1], vlo[2], vlo[3], vhi[0], vhi[1], vhi[2], vhi[3]};
                      oA1 = mfma32(vf, paA[hh][u2], oA1); oB1 = mfma32(vf, paB[hh][u2], oB1); } }
            if (t + 1 < NT) { *(u32x4*)(lds + (buf ^ 1) * 9216 + srow * 144 + sch * 16) = kreg; *(u32x4*)(lds + 18432 + (buf ^ 1) * 9216 + srow * 144 + sch * 16) = vreg; }
            __syncthreads();
        }
        lA += __shfl_xor(lA, 32); lB += __shfl_xor(lB, 32);
        const float invA = 1.f / lA, invB = 1.f / lB;
        bf16_t* ypA = Y + (size_t)qrowA * YLD + 1024 + head * 64; bf16_t* ypB = ypA + (size_t)32 * YLD;
#pragma unroll
        for (int rg = 0; rg < 4; ++rg) { const int d = 8 * rg + 4 * hi; u32x2 w;
            w.x = cvt_pk(oA0[4 * rg] * invA, oA0[4 * rg + 1] * invA); w.y = cvt_pk(oA0[4 * rg + 2] * invA, oA0[4 * rg + 3] * invA); *(u32x2*)(ypA + d) = w;
            w.x = cvt_pk(oA1[4 * rg] * invA, oA1[4 * rg + 1] * invA); w.y = cvt_pk(oA1[4 * rg + 2] * invA, oA1[4 * rg + 3] * invA); *(u32x2*)(ypA + 32 + d) = w;
            w.x = cvt_pk(oB0[4 * rg] * invB, oB0[4 * rg + 1] * invB); w.y = cvt_pk(oB0[4 * rg + 2] * invB, oB0[4 * rg + 3] * invB); *(u32x2*)(ypB + d) = w;
            w.x = cvt_pk(oB1[4 * rg] * invB, oB1[4 * rg + 1] * invB); w.y = cvt_pk(oB1[4 * rg + 2] * invB, oB1[4 * rg + 3] * invB); *(u32x2*)(ypB + 32 + d) = w; }
    }
}

__device__ __forceinline__ float gelu_tanh(float a) { const float e = __builtin_amdgcn_exp2f(a * (2.3022081984f + 0.1029432396f * (a * a))); return a - a * frcp(e + 1.f);   }
__device__ __forceinline__ void unpack8(const u32x4 w, float* x) { x[0] = bflo(w.x); x[1] = bfhi(w.x); x[2] = bflo(w.y); x[3] = bfhi(w.y); x[4] = bflo(w.z); x[5] = bfhi(w.z); x[6] = bflo(w.w); x[7] = bfhi(w.w); }
__device__ __forceinline__ void conv_act(const int TIDX, const int BIDX, const int GDIM, const bf16_t* U, bf16_t* ACT, const float* cw, const float* cb, int N) {
    const int gthreads = GDIM * 512, gtid = BIDX * 512 + TIDX;
    constexpr int NCG = DFF / 8;
    for (int it = gtid; it < (T / 16) * NCG; it += gthreads) {
        const int cg8 = it % NCG, run = it / NCG, row0 = run * 16, t0 = row0 % N, c0 = cg8 * 8;
        float wa[3][8], wg[3][8], ba[8], bg[8];
#pragma unroll
        for (int k = 0; k < 3; ++k)
#pragma unroll
            for (int e = 0; e < 8; ++e) { wa[k][e] = cw[k * DFF2 + c0 + e]; wg[k][e] = cw[k * DFF2 + DFF + c0 + e]; }
#pragma unroll
        for (int e = 0; e < 8; ++e) { ba[e] = cb[c0 + e]; bg[e] = cb[DFF + c0 + e]; }
        float pa[8], pg[8], ca[8], cgv[8], na[8], ng[8];
        const u32x4 zero = (u32x4){0u, 0u, 0u, 0u};
        { const u32x4 a = t0 > 0 ? *(const u32x4*)(U + (size_t)(row0 - 1) * DFF2 + c0) : zero; const u32x4 g = t0 > 0 ? *(const u32x4*)(U + (size_t)(row0 - 1) * DFF2 + DFF + c0) : zero; unpack8(a, pa); unpack8(g, pg); }
        { const u32x4 a = *(const u32x4*)(U + (size_t)row0 * DFF2 + c0); const u32x4 g = *(const u32x4*)(U + (size_t)row0 * DFF2 + DFF + c0); unpack8(a, ca); unpack8(g, cgv); }
#pragma unroll 4
        for (int i = 0; i < 16; ++i) { const int row = row0 + i; const bool hasn = (t0 + i + 1) < N;
            const u32x4 a = hasn ? *(const u32x4*)(U + (size_t)(row + 1) * DFF2 + c0) : zero; const u32x4 g = hasn ? *(const u32x4*)(U + (size_t)(row + 1) * DFF2 + DFF + c0) : zero; unpack8(a, na); unpack8(g, ng);
            float r[8];
#pragma unroll
            for (int e = 0; e < 8; ++e) { const float av = pa[e] * wa[0][e] + ca[e] * wa[1][e] + na[e] * wa[2][e] + ba[e]; const float gv = pg[e] * wg[0][e] + cgv[e] * wg[1][e] + ng[e] * wg[2][e] + bg[e]; r[e] = gelu_tanh(av) * gv; }
            u32x4 o; o.x = cvt_pk(r[0], r[1]); o.y = cvt_pk(r[2], r[3]); o.z = cvt_pk(r[4], r[5]); o.w = cvt_pk(r[6], r[7]);
            *(u32x4*)(ACT + (size_t)row * DFF + c0) = o;
#pragma unroll
            for (int e = 0; e < 8; ++e) { pa[e] = ca[e]; pg[e] = cgv[e]; ca[e] = na[e]; cgv[e] = ng[e]; } }
    }
}


constexpr size_t WS_BAR = 256 * 1024;
#define XB_TMO      128
#define XB_XCNT(j)  (256  + 64 * (j))
#define XB_XSUB(j)  (1280 + 64 * (j))
#define XB_XGEN(j)  (2304 + 64 * (j))
#define XB_TOP      3328
#define XB_TOPGEN   3392
#define XCD_BAR_WORDS 3456
#define XB_SPIN_CAP (1u << 22)
__device__ __forceinline__ unsigned xb_ld(unsigned* p)              { return __hip_atomic_load(p, __ATOMIC_RELAXED, __HIP_MEMORY_SCOPE_AGENT); }
__device__ __forceinline__ unsigned xb_add(unsigned* p, unsigned v) { return __hip_atomic_fetch_add(p, v, __ATOMIC_RELAXED, __HIP_MEMORY_SCOPE_AGENT); }
__device__ __forceinline__ unsigned xb_xcc_id() { return (unsigned)__builtin_amdgcn_s_getreg((3 << 11) | 20) & 0xFu; }
#define XB_SPIN(cond, bar) do { unsigned _sp = 0; while (cond) { __builtin_amdgcn_s_sleep(1); \
    if ((++_sp & 255u) == 0u) { if (xb_ld(&(bar)[XB_TMO])) break; if (_sp > XB_SPIN_CAP) { atomicAdd(&(bar)[XB_TMO], 1u); break; } } } } while (0)
struct XcdBarrier { unsigned* bar; unsigned x; volatile LAS unsigned* st; };
__device__ __forceinline__ XcdBarrier xcd_barrier_post(unsigned* bar, volatile LAS unsigned* st) {
    XcdBarrier b; b.bar = bar; b.x = xb_xcc_id(); b.st = st;
    if (threadIdx.x == 0) (void)xb_add(&bar[XB_XCNT(b.x)], 1u);
    return b;
}
__device__ __forceinline__ void xcd_barrier_complete(unsigned* bar, unsigned x, unsigned& nloc, unsigned& nx) {
    const unsigned G = gridDim.x * gridDim.y * gridDim.z;
    unsigned sum, cnt, mine, sp = 0u;
    for (;;) {
        sum = 0u; cnt = 0u; mine = 0u;
#pragma unroll
        for (unsigned j = 0; j < 16; ++j) { const unsigned c = xb_ld(&bar[XB_XCNT(j)]); sum += c; cnt += (c > 0u) ? 1u : 0u; mine = (j == x) ? c : mine; }
        if (sum == G) break;
        __builtin_amdgcn_s_sleep(1);
        if ((++sp & 255u) == 0u) { if (xb_ld(&bar[XB_TMO])) break; if (sp > XB_SPIN_CAP) { atomicAdd(&bar[XB_TMO], 1u); break; } }
    }
    nloc = mine > 0u ? mine : 1u; nx = cnt > 0u ? cnt : 1u;
}
__device__ __forceinline__ void xcd_barrier(const XcdBarrier& b) {
    asm volatile("s_waitcnt vmcnt(0)" ::: "memory");
    __syncthreads();
    if (threadIdx.x == 0) {
        unsigned* bar = b.bar;
        __builtin_amdgcn_s_waitcnt(0);
        unsigned nloc = b.st[0], nx = b.st[1];
        if (nloc == 0u) { xcd_barrier_complete(bar, b.x, nloc, nx); b.st[0] = nloc; b.st[1] = nx; }
        const unsigned old = xb_add(&bar[XB_XSUB(b.x)], 1u);
        const unsigned gen = old / nloc;
        if (old + 1u == (gen + 1u) * nloc) {
            __builtin_amdgcn_fence(__ATOMIC_RELEASE, "agent");
            asm volatile("s_waitcnt vmcnt(0)" ::: "memory");
            const unsigned og = xb_add(&bar[XB_TOP], 1u);
            const unsigned tg = og / nx;
            if (og + 1u == (tg + 1u) * nx) xb_add(&bar[XB_TOPGEN], 1u);
            else XB_SPIN(xb_ld(&bar[XB_TOPGEN]) == tg, bar);
            __builtin_amdgcn_fence(__ATOMIC_ACQUIRE, "agent");
            xb_add(&bar[XB_XGEN(b.x)], 1u);
            asm volatile("s_waitcnt vmcnt(0)" ::: "memory");
        } else {
            XB_SPIN(xb_ld(&bar[XB_XGEN(b.x)]) == gen, bar);
            __builtin_amdgcn_fence(__ATOMIC_ACQUIRE, "agent");
            asm volatile("s_waitcnt vmcnt(0)" ::: "memory");
        }
    }
    __syncthreads();
}

__device__ __forceinline__ void conv_fix(const int TIDX, const int BIDX, const int GDIM, const bf16_t* EB, bf16_t* ACT, const float* cw, const float* cb, int N) {
    const int gthreads = GDIM * 512, gtid = BIDX * 512 + TIDX;
    constexpr int NCG = DFF / 8;
    for (int it = gtid; it < (T / 64) * 2 * NCG; it += gthreads) {
        const int cg8 = it % NCG, be = it / NCG, edge = be & 1, blk = be >> 1, c0 = cg8 * 8;
        const int row = blk * 64 + (edge ? 63 : 0), t = row % N;
        const bf16_t* pP = edge ? EB + ((size_t)blk * 4 + 2) * DFF2 : EB + ((size_t)(blk - 1) * 4 + 3) * DFF2;
        const bf16_t* pC = EB + ((size_t)blk * 4 + (edge ? 3 : 0)) * DFF2;
        const bf16_t* pN = edge ? EB + ((size_t)(blk + 1) * 4 + 0) * DFF2 : EB + ((size_t)blk * 4 + 1) * DFF2;
        const bool hasp = t > 0, hasn = t + 1 < N;
        const u32x4 zero = (u32x4){0u, 0u, 0u, 0u};
        float pa[8], pg[8], ca[8], cg[8], na[8], ng[8];
        unpack8(hasp ? *(const u32x4*)(pP + c0) : zero, pa); unpack8(hasp ? *(const u32x4*)(pP + DFF + c0) : zero, pg);
        unpack8(*(const u32x4*)(pC + c0), ca); unpack8(*(const u32x4*)(pC + DFF + c0), cg);
        unpack8(hasn ? *(const u32x4*)(pN + c0) : zero, na); unpack8(hasn ? *(const u32x4*)(pN + DFF + c0) : zero, ng);
        float r[8];
#pragma unroll
        for (int e = 0; e < 8; ++e) { const float av = pa[e] * cw[c0 + e] + ca[e] * cw[DFF2 + c0 + e] + na[e] * cw[2 * DFF2 + c0 + e] + cb[c0 + e];
            const float gv = pg[e] * cw[DFF + c0 + e] + cg[e] * cw[DFF2 + DFF + c0 + e] + ng[e] * cw[2 * DFF2 + DFF + c0 + e] + cb[DFF + c0 + e]; r[e] = gelu_tanh(av) * gv; }
        u32x4 o; o.x = cvt_pk(r[0], r[1]); o.y = cvt_pk(r[2], r[3]); o.z = cvt_pk(r[4], r[5]); o.w = cvt_pk(r[6], r[7]);
        *(u32x4*)(ACT + (size_t)row * DFF + c0) = o;
    }
}

constexpr int STEPS_PER_GROUP = 42, NSTEPS = 1 + NGROUP * STEPS_PER_GROUP;

__global__ void __launch_bounds__(512, 2) mega(Params P) {
    extern __shared__ __attribute__((aligned(16))) unsigned char lds[];
    LAS unsigned char* lds3 = (LAS unsigned char*)lds;
    typedef __attribute__((address_space(4))) const unsigned char* kaptr_t;
    const kaptr_t ka = (kaptr_t)__builtin_amdgcn_kernarg_segment_ptr();
#define KIN(i) (*(const float* const volatile __attribute__((address_space(4)))*)(ka + 8 * (i)))
#define KOUT (*(float* const volatile __attribute__((address_space(4)))*)(ka + 8 * 26))
#define KWS (*(unsigned char* const volatile __attribute__((address_space(4)))*)(ka + 8 * 27))
#define KLO (*(const volatile int __attribute__((address_space(4)))*)(ka + 8 * 28))
#define KHI (*(const volatile int __attribute__((address_space(4)))*)(ka + 8 * 28 + 4))
    const int step_hi = KHI;
    volatile LAS unsigned* MISC = (volatile LAS unsigned*)(lds3 + 131072 + 320);
    if (threadIdx.x < 32) MISC[threadIdx.x] = 0u;
    __syncthreads();
    XcdBarrier gbar = xcd_barrier_post((unsigned*)(KWS + WS_BAR), MISC + 8);
    bool first_sync = true;
    for (int step = KLO; step < step_hi; ++step) {
        unsigned char* ws = KWS;
        int tid_o = threadIdx.x, bx_o = blockIdx.x, G_o = gridDim.x;
        asm volatile("" : "+v"(tid_o)); asm volatile("" : "+s"(bx_o)); asm volatile("" : "+s"(G_o));
        const int G = G_o, bx = bx_o;
        if (step == 0) { phase0(tid_o, bx_o, G_o, ka, lds); }
        else {
            const int g = (step - 1) / STEPS_PER_GROUP, s = (step - 1) % STEPS_PER_GROUP;
            const int N = g == 0 ? 4096 : 8192;
            const float* xin = g == 0 ? KIN(0) : KIN(1) + (size_t)(g - 1) * T * DM;
            float* xout = KOUT + (size_t)g * T * DM;
            bf16_t* XB0 = (bf16_t*)(ws + WS_XB0); bf16_t* XB1 = (bf16_t*)(ws + WS_XB1);
            float* RSS0 = (float*)(ws + WS_RSS); float* RSS1 = RSS0 + (size_t)T * 16;
            bf16_t* Z = (bf16_t*)(ws + WS_Z); bf16_t* YC = (bf16_t*)(ws + WS_YCAT); bf16_t* MG = (bf16_t*)(ws + WS_MERGED);
            bf16_t* ST = (bf16_t*)(ws + WS_ST); bf16_t* FACC = (bf16_t*)(ws + WS_ST); bf16_t* VT = (bf16_t*)(ws + WS_VT); float* DEC = (float*)(ws + WS_DEC);
            bf16_t* ACT = YC; bf16_t* EB = (bf16_t*)(ws + WS_ST + 32 * MiB);
            if (s == 0) group_init(tid_o, bx_o, G_o, xin, XB0, RSS0);
            else if (s == 41) final_norm(tid_o, bx_o, G_o, xout, RSS0, KIN(25));
            else {
                const int layer = (s - 1) / 10, ls = (s - 1) % 10, cur = layer & 1;
                bf16_t* XBc = cur ? XB1 : XB0; bf16_t* XBn = cur ? XB0 : XB1;
                float* RSSc = cur ? RSS1 : RSS0; float* RSSn = cur ? RSS0 : RSS1;
                const float* LBl = (const float*)(ws + WS_LB) + layer * 1024;
                const float* xbase = layer == 0 ? xin : xout;
                if (ls == 0) {
                    pg8::Gemm gm{XBc, (const bf16_t*)(ws + WS_WIN) + (size_t)layer * INW * DM, XBLD, DM};
                    pg8::Sched<INW, 1, 0, 16, 0, 0, 0, 0> S{G, bx};
                    pg8::EpiScale E{Z, INW, RSSc, OFF_GATE / 256};
                    pg8::gemm_phase(tid_o, bx_o, G_o, lds3, gm, S, E);
                } else if (ls == 1) {
                    const float* pin = (g == 0 ? KIN(2) + (size_t)layer * 16384 * PLE : KIN(3) + (size_t)layer * 32768 * PLE + (size_t)(g - 1) * T * PLE);
                    prep_p(tid_o, bx_o, G_o, pin, XBc);
                    prep_qk(tid_o, bx_o, G_o, Z, (const f32x2*)(ws + WS_CS), KIN(11) + layer * 64, KIN(12) + layer * 64, N);
                    prep_vt(tid_o, bx_o, G_o, Z, VT, N, lds);
                    prep_pool(tid_o, bx_o, G_o, Z, YC, N);
                    hg_pass1(tid_o, bx_o, G_o, Z, ST, DEC, LBl, N, lds);
                } else if (ls == 2) {
                    hg_scan(tid_o, bx_o, G_o, ST, DEC, N);
                } else if (ls == 3) {
                    hg_pass3(tid_o, bx_o, G_o, Z, ST, YC, LBl, KIN(10) + layer * 128, N, lds);
                    attn_phase(tid_o, bx_o, G_o, Z, VT, YC, KIN(11) + layer * 64, KIN(12) + layer * 64, N, lds);
                } else if (ls == 4) {
                    pg8::Gemm gm{YC, (const bf16_t*)(ws + WS_WCAT) + (size_t)layer * DM * YLD, YLD, YLD};
                    pg8::Sched<DM, 3, 0, 8, 512, 8, 1024, 16> S{G, bx};
                    pg8::EpiMerge E{Z, FACC, MG};
                    pg8::gemm_phase(tid_o, bx_o, G_o, lds3, gm, S, E);
                } else if (ls == 5) {
                    pg8::Gemm gm{MG, (const bf16_t*)(ws + WS_WOUT) + (size_t)layer * DM * DM, DM, DM};
                    pg8::Sched<DM, 1, 0, 16, 0, 0, 0, 0> S{G, bx};
                    pg8::EpiX<0> E{XBc, xout, XBc, RSSn, nullptr, nullptr, 0};
                    pg8::gemm_phase(tid_o, bx_o, G_o, lds3, gm, S, E);
                } else if (ls == 6) {
                    pg8::Gemm gm{XBc, (const bf16_t*)(ws + WS_WUP) + (size_t)layer * DFF2 * DM, XBLD, DM};
                    pg8::Sched<DFF2, 1, 0, 16, 0, 0, 0, 0> S{G, bx};
                    pg8::EpiUp E{ws, layer, cur ^ 1};
                    pg8::gemm_phase(tid_o, bx_o, G_o, lds3, gm, S, E);
                } else if (ls == 7) {
                    conv_fix(tid_o, bx_o, G_o, EB, ACT, KIN(19) + (size_t)layer * 3 * DFF2, KIN(20) + (size_t)layer * DFF2, N);
                } else if (ls == 8) {
                    pg8::Gemm gm{ACT, (const bf16_t*)(ws + WS_WDOWN) + (size_t)layer * DM * DFF, DFF, DFF};
                    pg8::Sched<DM, 1, 0, 44, 0, 0, 0, 0> S{G, bx};
                    pg8::EpiX<0> E{XBc, xout, XBc, RSSc, nullptr, nullptr, 0};
                    pg8::gemm_phase(tid_o, bx_o, G_o, lds3, gm, S, E);
                } else {
                    pg8::Gemm gm{XBc, (const bf16_t*)(ws + WS_WPG) + (size_t)layer * DM * WPGLD, XBLD, WPGLD};
                    pg8::Sched<DM, 2, 1024, 4, 0, 16, 0, 0> S{G, bx};
                    pg8::EpiX<1> E{XBc, xout, XBn, RSSn, RSSc, FACC, layer == 3 ? 1 : 0};
                    pg8::gemm_phase(tid_o, bx_o, G_o, lds3, gm, S, E);
                }
            }
        }
        if (step + 1 < step_hi) { if (first_sync) { cg::this_grid().sync(); first_sync = false; } else xcd_barrier(gbar); }
    }
}


extern "C" void kernel_launch(void* const* d_in, const int* in_sizes, int n_in, void* d_out, int out_size, void* d_ws, size_t ws_size, hipStream_t stream) {
    static int grid = 0;
    if (grid == 0) {
        if (n_in != 26 || ws_size < WS_END) { fprintf(stderr, "kernel_launch: unexpected n_in %d or ws_size %zu (< %zu)\n", n_in, ws_size, (size_t)WS_END); grid = -1; return; }
        int dev = 0, cus = 0, per_cu = 0;
        hipGetDevice(&dev); hipDeviceGetAttribute(&cus, hipDeviceAttributeMultiprocessorCount, dev);
        hipFuncSetAttribute((const void*)mega, hipFuncAttributeMaxDynamicSharedMemorySize, LDS_BYTES);
        hipOccupancyMaxActiveBlocksPerMultiprocessor(&per_cu, (const void*)mega, 512, LDS_BYTES);
        (void)hipGetLastError();
        if (per_cu < 1) per_cu = 1;
        grid = cus * 1;
        fprintf(stderr, "kernel_launch: cus %d per_cu %d grid %d ws %zu\n", cus, per_cu, grid, ws_size);
    }
    if (grid < 0) return;
    Params p{};
    for (int i = 0; i < 26; ++i) p.in[i] = (const float*)d_in[i];
    p.out = (float*)d_out; p.ws = (unsigned char*)d_ws;
#if ONE_LAUNCH
    p.lo = 0; p.hi = NSTEPS;
    if (hipMemsetAsync((unsigned char*)d_ws + WS_BAR, 0, XCD_BAR_WORDS * 4, stream) != hipSuccess) fprintf(stderr, "memset failed\n");
    void* args[] = {&p};
    hipError_t e = hipLaunchCooperativeKernel((const void*)mega, dim3(grid), dim3(512), args, LDS_BYTES, stream);
    if (e != hipSuccess) fprintf(stderr, "cooperative launch failed: %s\n", hipGetErrorString(e));
#else
    for (int s = 0; s < NSTEPS; ++s) { p.lo = s; p.hi = s + 1; hipLaunchKernelGGL(mega, dim3(grid), dim3(512), LDS_BYTES, stream, p); }
#endif
}
```

```cpp
#include <hip/hip_runtime.h>
#include <hip/hip_cooperative_groups.h>
#include <cstdio>
#include <cstdint>
namespace cg = cooperative_groups;

#ifndef ONE_LAUNCH
#define ONE_LAUNCH 1
#endif

#define LAS __attribute__((address_space(3)))
typedef unsigned short bf16_t;
typedef short bf16x8 __attribute__((ext_vector_type(8)));
typedef short s16x4 __attribute__((ext_vector_type(4)));
typedef float f32x4 __attribute__((ext_vector_type(4)));
typedef float f32x2 __attribute__((ext_vector_type(2)));
typedef float f32x16 __attribute__((ext_vector_type(16)));
typedef unsigned u32x4 __attribute__((ext_vector_type(4)));
typedef unsigned u32x2 __attribute__((ext_vector_type(2)));

constexpr int DM = 1024, DEPTH = 4, PLE = 256, DFF = 2816, DFF2 = 5632;
constexpr int OFF_POOL = 0, OFF_HQ = 512, OFF_HFF = 1024, OFF_HFB = 1536, OFF_HI = 2048, OFF_HG = 2560, OFF_AQ = 3072, OFF_AK = 4096, OFF_AV = 4352, OFF_GATE = 4608, INW = 7680;
constexpr int T = 16384;
constexpr int NGROUP = 3;
constexpr float EPS = 1e-6f;
constexpr int XBLD = 1280;
constexpr int YLD = 2048;
constexpr int WPGLD = 1280;

constexpr size_t MiB = 1u << 20;
constexpr size_t WS_CS = 0;
constexpr size_t WS_LB = 64 * 1024;
constexpr size_t WS_WIN = 1 * MiB;
constexpr size_t WS_WCAT = 61 * MiB;
constexpr size_t WS_WOUT = 77 * MiB;
constexpr size_t WS_WUP = 85 * MiB;
constexpr size_t WS_WDOWN = 129 * MiB;
constexpr size_t WS_WPG = 151 * MiB;
constexpr size_t WS_XB0 = 161 * MiB;
constexpr size_t WS_XB1 = 201 * MiB;
constexpr size_t WS_RSS = 241 * MiB;
constexpr size_t WS_Z = 243 * MiB;
constexpr size_t WS_YCAT = 483 * MiB;
constexpr size_t WS_MERGED = 547 * MiB;
constexpr size_t WS_ST = 579 * MiB;
constexpr size_t WS_VT = 643 * MiB;
constexpr size_t WS_DEC = 651 * MiB;
constexpr size_t WS_END = 652 * MiB;

constexpr int LDS_BYTES = 153600;

typedef __bf16 bf16x2_t __attribute__((ext_vector_type(2)));
__device__ __forceinline__ unsigned cvt_pk(float lo, float hi) { f32x2 v = {lo, hi}; bf16x2_t b = __builtin_convertvector(v, bf16x2_t); return __builtin_bit_cast(unsigned, b); }
__device__ __forceinline__ float bf2f(bf16_t h) { return __uint_as_float((unsigned)h << 16); }
__device__ __forceinline__ float bflo(unsigned w) { return __uint_as_float(w << 16); }
__device__ __forceinline__ float bfhi(unsigned w) { return __uint_as_float(w & 0xffff0000u); }
__device__ __forceinline__ bf16_t f2bf(float f) { return (bf16_t)(cvt_pk(f, 0.f) & 0xffffu); }
__device__ __forceinline__ float frcp(float x) { return __builtin_amdgcn_rcpf(x); }
__device__ __forceinline__ float sigm(float x) { return frcp(1.f + __expf(-x)); }
__device__ __forceinline__ int crow(int r, int hi) { return (r & 3) + 8 * (r >> 2) + 4 * hi; }
__device__ __forceinline__ f32x16 mfma32(bf16x8 x, bf16x8 y, f32x16 c) { return __builtin_amdgcn_mfma_f32_32x32x16_bf16(x, y, c, 0, 0, 0); }
__device__ __forceinline__ float wave_sum(float v) {
#pragma unroll
    for (int o = 1; o < 64; o <<= 1) v += __shfl_xor(v, o);
    return v;
}

__device__ __forceinline__ float gelu_tanh_e(float a) { const float e = __builtin_amdgcn_exp2f(a * (2.3022081984f + 0.1029432396f * (a * a))); return a - a * frcp(e + 1.f);   }

constexpr size_t WS_RSS_OFF = 241u * 1048576u, WS_ACT_OFF = 483u * 1048576u, WS_EB_OFF = (579u + 32u) * 1048576u;
extern __shared__ __attribute__((aligned(16))) unsigned char g_lds[];
namespace pg8 {
constexpr int BM = 256, BK = 64, HALF = 128, HTB = HALF * BK * 2, STAGE_BYTES = 8 * HTB, NXCD = 8, WGM = 8;
__host__ __device__ __forceinline__ int lds_byte(int r, int c) { const int st = (r >> 4) * 2 + (c >> 5), rr = r & 15, cc = c & 31, ob = rr * 64 + cc * 2; return st * 1024 + (ob ^ (((ob >> 9) & 1) << 5)); }
__host__ __device__ __forceinline__ void stage_rc(int b, int& R, int& C) { const int st = b / 1024, sb = b % 1024, swz = sb ^ (((sb >> 9) & 1) << 5); R = (st >> 1) * 16 + swz / 64; C = (st & 1) * 32 + (swz % 64) / 2; }
__host__ __device__ __forceinline__ int perm32(int rho) { const int n = rho >> 4, i = rho & 15; return 8 * (i >> 2) + 4 * n + (i & 3); }

struct Unit { int pm, pn, br, koff, nt; };
struct Gemm { const bf16_t* A; const bf16_t* Bt; int lda, ldb; };

template <int N_, int NBR, int K0, int T0, int K1, int T1, int K2, int T2>
struct Sched {
    int G, c;
    static constexpr int nM = 16384 / BM, nN = N_ / BM, nwg = nM * nN;
    __device__ __forceinline__ bool next(int i, Unit& u) const {
        const int ti = i / NBR, br = i - ti * NBR;
        const int L = ti * G + c; if (L >= nwg) return false;
        int wgid = L; { constexpr int q = nwg / NXCD, r = nwg % NXCD; const int xcd = wgid % NXCD, off = wgid / NXCD; wgid = (xcd < r ? xcd * (q + 1) : r * (q + 1) + (xcd - r) * q) + off; }
        constexpr int nig = WGM * nN; const int gid = wgid / nig, fm = gid * WGM, gsz = (nM - fm) < WGM ? (nM - fm) : WGM;
        u.pm = fm + ((wgid % nig) % gsz); u.pn = (wgid % nig) / gsz; u.br = br;
        u.koff = br == 0 ? K0 : (br == 1 ? K1 : K2); u.nt = br == 0 ? T0 : (br == 1 ? T1 : T2);
        return true;
    }
};

template <class Epi, class SchedT>
__device__ __forceinline__ void gemm_phase(const int TIDX, const int BIDX, const int GDIM, LAS unsigned char* lds, const Gemm g, const SchedT& S, const Epi& E) {
    const int tid = TIDX, wid = __builtin_amdgcn_readfirstlane(tid >> 6), lane = tid & 63, wr = wid >> 2, wc = wid & 3, fr = lane & 15, fq = lane >> 4;
    unsigned voffA[2], voffB[2];
#pragma unroll
    for (int i = 0; i < 2; ++i) { int R, C; stage_rc(tid * 16 + i * 8192, R, C); const int Rb = (R & ~31) + perm32(R & 31);
        voffA[i] = (unsigned)(R * g.lda + C) * 2u; voffB[i] = (unsigned)(Rb * g.ldb + C) * 2u; }
    const size_t kstep = (size_t)(BK * 2);
    const size_t hstepA = (size_t)HALF * g.lda * 2, hstepB = (size_t)HALF * g.ldb * 2;
    const size_t tstepA = 2 * hstepA, tstepB = 2 * hstepB;
    const unsigned ldsw = (unsigned)wid * 1024u;
    const int aoff = lds_byte(wr * 64 + fr, fq * 8), boff = lds_byte(wc * 32 + fr, fq * 8);
#define PG8_SA(b, h) (((b) * 2 + (h)) * HTB)
#define PG8_SB(b, h) ((4 + (b) * 2 + (h)) * HTB)
#define PG8_STAGE(bufoff, gbase, voff) do { _Pragma("unroll") for (int _i = 0; _i < 2; ++_i) \
        __builtin_amdgcn_global_load_lds((const unsigned*)((const char*)(gbase) + (voff)[_i]), (LAS unsigned*)(lds + (bufoff) + ldsw + _i * 8192), 16, 0, 0); } while (0)
#define PG8_LDA(dst, b, h) do { _Pragma("unroll") for (int m = 0; m < 4; ++m) _Pragma("unroll") for (int k = 0; k < 2; ++k) dst[m][k] = *(const LAS bf16x8*)(lds + PG8_SA(b, h) + aoff + m * 2048 + k * 1024); } while (0)
#define PG8_LDB(dst, b, h) do { _Pragma("unroll") for (int n = 0; n < 2; ++n) _Pragma("unroll") for (int k = 0; k < 2; ++k) dst[n][k] = *(const LAS bf16x8*)(lds + PG8_SB(b, h) + boff + n * 2048 + k * 1024); } while (0)
#define PG8_MMA(ai, bj, At, Bt) do { __builtin_amdgcn_s_setprio(1); _Pragma("unroll") for (int m = 0; m < 4; ++m) _Pragma("unroll") for (int n = 0; n < 2; ++n) _Pragma("unroll") for (int k = 0; k < 2; ++k) \
        acc[ai][bj][m][n] = __builtin_amdgcn_mfma_f32_16x16x32_bf16(Bt[n][k], At[m][k], acc[ai][bj][m][n], 0, 0, 0); __builtin_amdgcn_s_setprio(0); } while (0)
#define PG8_WAIT_V(n) asm volatile("s_waitcnt vmcnt(" #n ")" ::: "memory")
#define PG8_WAIT_L(n) asm volatile("s_waitcnt lgkmcnt(" #n ")" ::: "memory")
#define PG8_BAR __builtin_amdgcn_s_barrier()
#define PG8_SCHED __builtin_amdgcn_sched_barrier(0)
    Unit cur, nxt; int ui = 0;
    if (!S.next(0, cur)) return;
    f32x4 acc[2][2][4][2];
#pragma unroll
    for (int a = 0; a < 2; ++a)
#pragma unroll
        for (int b = 0; b < 2; ++b)
#pragma unroll
            for (int m = 0; m < 4; ++m)
#pragma unroll
                for (int n = 0; n < 2; ++n) acc[a][b][m][n] = (f32x4){0.f, 0.f, 0.f, 0.f};
    bf16x8 At[4][2], B0[2][2], B1[2][2];
    const char* cA = (const char*)g.A + (size_t)cur.pm * tstepA + (size_t)cur.koff * 2; const char* cB = (const char*)g.Bt + (size_t)cur.pn * tstepB + (size_t)cur.koff * 2;
    PG8_STAGE(PG8_SB(0, 0), cB, voffB); PG8_STAGE(PG8_SB(0, 1), cB + hstepB, voffB); PG8_STAGE(PG8_SA(0, 0), cA, voffA); PG8_STAGE(PG8_SA(0, 1), cA + hstepA, voffA);
    if (wr == 1) PG8_BAR;
    PG8_WAIT_V(2); PG8_BAR;
    PG8_STAGE(PG8_SB(1, 0), cB + kstep, voffB); PG8_STAGE(PG8_SA(1, 0), cA + kstep, voffA); PG8_STAGE(PG8_SB(1, 1), cB + hstepB + kstep, voffB);
    PG8_WAIT_V(6); PG8_BAR;
    for (;;) {
        const bool has_next = S.next(ui + 1, nxt);
        const int nt = cur.nt;
        const char* nA = has_next ? (const char*)g.A + (size_t)nxt.pm * tstepA + (size_t)nxt.koff * 2 : cA; const char* nB = has_next ? (const char*)g.Bt + (size_t)nxt.pn * tstepB + (size_t)nxt.koff * 2 : cB;
        for (int t = 0; t < nt; t += 2) {
            const bool last = (t == nt - 2);
            const char* a1 = cA + (size_t)(t + 1) * kstep;
            const char* a2 = last ? nA : cA + (size_t)(t + 2) * kstep; const char* b2 = last ? nB : cB + (size_t)(t + 2) * kstep;
            const char* a3 = a2 + kstep; const char* b3 = b2 + kstep;
            PG8_LDB(B0, 0, 0); PG8_LDB(B1, 0, 1); PG8_SCHED; PG8_LDA(At, 0, 0); PG8_STAGE(PG8_SA(1, 1), a1 + hstepA, voffA);
            PG8_WAIT_V(8); PG8_WAIT_L(0); PG8_BAR; PG8_MMA(0, 0, At, B0); PG8_MMA(0, 1, At, B1); PG8_BAR; PG8_SCHED;
            PG8_LDA(At, 0, 1); PG8_STAGE(PG8_SB(0, 0), b2, voffB); PG8_STAGE(PG8_SB(0, 1), b2 + hstepB, voffB); PG8_STAGE(PG8_SA(0, 0), a2, voffA);
            PG8_WAIT_V(8); PG8_WAIT_L(0); PG8_BAR; PG8_MMA(1, 0, At, B0); PG8_MMA(1, 1, At, B1); PG8_BAR; PG8_SCHED;
            PG8_LDB(B0, 1, 0); PG8_LDB(B1, 1, 1); PG8_SCHED; PG8_LDA(At, 1, 0); PG8_STAGE(PG8_SA(0, 1), a2 + hstepA, voffA);
            PG8_WAIT_V(8); PG8_WAIT_L(0); PG8_BAR; PG8_MMA(0, 0, At, B0); PG8_MMA(0, 1, At, B1); PG8_BAR; PG8_SCHED;
            PG8_LDA(At, 1, 1); PG8_STAGE(PG8_SB(1, 0), b3, voffB); PG8_STAGE(PG8_SB(1, 1), b3 + hstepB, voffB); PG8_STAGE(PG8_SA(1, 0), a3, voffA);
            PG8_WAIT_V(8); PG8_WAIT_L(0); PG8_BAR; PG8_MMA(1, 0, At, B0); PG8_MMA(1, 1, At, B1); PG8_BAR; PG8_SCHED;
        }
        if (wr == 0) PG8_BAR;
        E(acc, cur, wr, wc, fr, fq);
        if (!has_next) break;
#pragma unroll
        for (int a = 0; a < 2; ++a)
#pragma unroll
            for (int b = 0; b < 2; ++b)
#pragma unroll
                for (int m = 0; m < 4; ++m)
#pragma unroll
                    for (int n = 0; n < 2; ++n) acc[a][b][m][n] = (f32x4){0.f, 0.f, 0.f, 0.f};
        cur = nxt; cA = nA; cB = nB; ++ui;
        if (wr == 1) PG8_BAR;
    }
    PG8_WAIT_V(0);
    PG8_BAR;
#undef PG8_SA
#undef PG8_SB
#undef PG8_STAGE
#undef PG8_LDA
#undef PG8_LDB
#undef PG8_MMA
#undef PG8_WAIT_V
#undef PG8_WAIT_L
#undef PG8_BAR
#undef PG8_SCHED
}

__device__ __forceinline__ float row_rinv(const float* rss, int row) {
    const f32x4* p = (const f32x4*)(rss + (size_t)row * 16);
    const f32x4 a = p[0], b = p[1], c = p[2], d = p[3];
    const float s = ((a[0] + a[1]) + (a[2] + a[3])) + ((b[0] + b[1]) + (b[2] + b[3])) + ((c[0] + c[1]) + (c[2] + c[3])) + ((d[0] + d[1]) + (d[2] + d[3]));
    return rsqrtf(s * (1.0f / DM) + EPS);
}
__device__ __forceinline__ float row_rinv_q(const float* rss, int row, int fq) {
    const f32x4 a = ((const f32x4*)(rss + (size_t)row * 16))[fq];
    float s = (a[0] + a[1]) + (a[2] + a[3]);
    s += __shfl_xor(s, 16); s += __shfl_xor(s, 32);
    return rsqrtf(s * (1.0f / DM) + EPS);
}
struct EpiScale {
    bf16_t* O; int ldc; const float* rss; int sig_pn; bf16_t* VT; int vpn, nshift;
    __device__ __forceinline__ void operator()(const f32x4 (&acc)[2][2][4][2], const Unit& u, int wr, int wc, int fr, int fq) const {
        const int col0 = u.pn * BM + wc * 32 + 8 * fq; const bool sg = u.pn >= sig_pn;
        if (u.pn == vpn) {
#pragma unroll
            for (int ai = 0; ai < 2; ++ai)
#pragma unroll
                for (int m = 0; m < 4; ++m) { const int row = u.pm * BM + ai * HALF + wr * 64 + m * 16 + fr; const float r = row_rinv(rss, row);
                    const int seq = row >> nshift, t = row & ((1 << nshift) - 1);
#pragma unroll
                    for (int bj = 0; bj < 2; ++bj) { const f32x4 v0 = acc[ai][bj][m][0] * r, v1 = acc[ai][bj][m][1] * r;
                        const int dcol = bj * HALF + wc * 32 + 8 * fq;
                        bf16_t* vp = VT + ((size_t)(seq * 256 + dcol) << nshift) + t;
#pragma unroll
                        for (int e = 0; e < 4; ++e) { vp[(size_t)e << nshift] = f2bf(v0[e]); vp[(size_t)(4 + e) << nshift] = f2bf(v1[e]); } }
                    asm volatile("" ::: "memory"); }
            return;
        }
#pragma unroll
        for (int ai = 0; ai < 2; ++ai)
#pragma unroll
            for (int m = 0; m < 4; ++m) { const int row = u.pm * BM + ai * HALF + wr * 64 + m * 16 + fr; const float r = row_rinv(rss, row);
                bf16_t* rowp = O + (size_t)row * ldc + col0;
#pragma unroll
                for (int bj = 0; bj < 2; ++bj) { f32x4 v0 = acc[ai][bj][m][0] * r, v1 = acc[ai][bj][m][1] * r;
                    if (sg) {
#pragma unroll
                        for (int e = 0; e < 4; ++e) { v0[e] = sigm(v0[e]); v1[e] = sigm(v1[e]); } }
                    u32x4 w; w.x = cvt_pk(v0[0], v0[1]); w.y = cvt_pk(v0[2], v0[3]); w.z = cvt_pk(v1[0], v1[1]); w.w = cvt_pk(v1[2], v1[3]);
                    __builtin_nontemporal_store(w, (u32x4*)(rowp + bj * HALF)); }
                asm volatile("" ::: "memory"); }
    }
};
struct EpiMerge {
    const bf16_t* Z; bf16_t* facc; bf16_t* merged;
    __device__ __forceinline__ void operator()(const f32x4 (&acc)[2][2][4][2], const Unit& u, int wr, int wc, int fr, int fq) const {
        const int col0 = u.pn * BM + wc * 32 + 8 * fq;
#pragma unroll
        for (int ai = 0; ai < 2; ++ai)
#pragma unroll
            for (int m = 0; m < 4; ++m) { const int row = u.pm * BM + ai * HALF + wr * 64 + m * 16 + fr;
#pragma unroll
                for (int bj = 0; bj < 2; ++bj) { const int col = col0 + bj * HALF;
                    const u32x4 gw = *(const u32x4*)(Z + (size_t)row * INW + OFF_GATE + u.br * DM + col);
                    f32x4 v0 = acc[ai][bj][m][0], v1 = acc[ai][bj][m][1];
                    v0[0] *= bflo(gw.x); v0[1] *= bfhi(gw.x); v0[2] *= bflo(gw.y); v0[3] *= bfhi(gw.y);
                    v1[0] *= bflo(gw.z); v1[1] *= bfhi(gw.z); v1[2] *= bflo(gw.w); v1[3] *= bfhi(gw.w);
                    bf16_t* fp = facc + (size_t)row * DM + col;
                    if (u.br > 0) { const u32x4 pw = *(const u32x4*)fp; v0[0] += bflo(pw.x); v0[1] += bfhi(pw.x); v0[2] += bflo(pw.y); v0[3] += bfhi(pw.y); v1[0] += bflo(pw.z); v1[1] += bfhi(pw.z); v1[2] += bflo(pw.w); v1[3] += bfhi(pw.w); }
                    if (u.br < 2) { u32x4 w; w.x = cvt_pk(v0[0], v0[1]); w.y = cvt_pk(v0[2], v0[3]); w.z = cvt_pk(v1[0], v1[1]); w.w = cvt_pk(v1[2], v1[3]); *(u32x4*)fp = w; }
                    else { u32x4 w; w.x = cvt_pk(v0[0], v0[1]); w.y = cvt_pk(v0[2], v0[3]); w.z = cvt_pk(v1[0], v1[1]); w.w = cvt_pk(v1[2], v1[3]);
                        *(u32x4*)(merged + (size_t)row * DM + col) = w; } }
                asm volatile("" ::: "memory"); }
    }
};
template <int MODE> struct EpiX {
    const bf16_t* baseb; float* out; bf16_t* xb; float* rss_out; const float* rss_in; bf16_t* facc; int wout;
    __device__ __forceinline__ void operator()(const f32x4 (&acc)[2][2][4][2], const Unit& u, int wr, int wc, int fr, int fq) const {
        const int col0 = u.pn * BM + wc * 32 + 8 * fq;
#pragma unroll
        for (int ai = 0; ai < 2; ++ai)
#pragma unroll
            for (int m = 0; m < 4; ++m) { const int row = u.pm * BM + ai * HALF + wr * 64 + m * 16 + fr;
                if (MODE == 1 && u.br == 0) {
#pragma unroll
                    for (int bj = 0; bj < 2; ++bj) { bf16_t* fp = facc + (size_t)row * DM + col0 + bj * HALF; const f32x4 a0 = acc[ai][bj][m][0], a1 = acc[ai][bj][m][1]; u32x4 w; w.x = cvt_pk(a0[0], a0[1]); w.y = cvt_pk(a0[2], a0[3]); w.z = cvt_pk(a1[0], a1[1]); w.w = cvt_pk(a1[2], a1[3]); *(u32x4*)fp = w; }
                } else {
                    float r = 1.f; if (MODE == 1) r = row_rinv(rss_in, row);
                    float ss = 0.f;
#pragma unroll
                    for (int bj = 0; bj < 2; ++bj) { const int col = col0 + bj * HALF; const size_t off = (size_t)row * DM + col;
                        f32x4 v0 = acc[ai][bj][m][0], v1 = acc[ai][bj][m][1];
                        if (MODE == 1) { const u32x4 pw = *(const u32x4*)(facc + off); const f32x4 p0 = (f32x4){bflo(pw.x), bfhi(pw.x), bflo(pw.y), bfhi(pw.y)}, p1 = (f32x4){bflo(pw.z), bfhi(pw.z), bflo(pw.w), bfhi(pw.w)};
#pragma unroll
                            for (int e = 0; e < 4; ++e) { v0[e] = sigm(v0[e] * r) * p0[e]; v1[e] = sigm(v1[e] * r) * p1[e]; } }
                        const u32x4 bw = *(const u32x4*)(baseb + (size_t)row * XBLD + col);
                        v0[0] += bflo(bw.x); v0[1] += bfhi(bw.x); v0[2] += bflo(bw.y); v0[3] += bfhi(bw.y); v1[0] += bflo(bw.z); v1[1] += bfhi(bw.z); v1[2] += bflo(bw.w); v1[3] += bfhi(bw.w);
                        if (wout) { *(f32x4*)(out + off) = v0; *(f32x4*)(out + off + 4) = v1; }
                        ss += (v0[0] * v0[0] + v0[1] * v0[1]) + (v0[2] * v0[2] + v0[3] * v0[3]) + (v1[0] * v1[0] + v1[1] * v1[1]) + (v1[2] * v1[2] + v1[3] * v1[3]);
                        u32x4 w; w.x = cvt_pk(v0[0], v0[1]); w.y = cvt_pk(v0[2], v0[3]); w.z = cvt_pk(v1[0], v1[1]); w.w = cvt_pk(v1[2], v1[3]);
                        *(u32x4*)(xb + (size_t)row * XBLD + col) = w; }
                    ss += __shfl_xor(ss, 16); ss += __shfl_xor(ss, 32);
                    if (fq == 0) rss_out[(size_t)row * 16 + u.pn * 4 + wc] = ss;
                }
                asm volatile("" ::: "memory"); }
    }
};
#define PIN_ACC_HALF(A) asm volatile("" : "+v"(acc[A][0][0][0]), "+v"(acc[A][0][0][1]), "+v"(acc[A][0][1][0]), "+v"(acc[A][0][1][1]), "+v"(acc[A][0][2][0]), "+v"(acc[A][0][2][1]), "+v"(acc[A][0][3][0]), "+v"(acc[A][0][3][1]), \
    "+v"(acc[A][1][0][0]), "+v"(acc[A][1][0][1]), "+v"(acc[A][1][1][0]), "+v"(acc[A][1][1][1]), "+v"(acc[A][1][2][0]), "+v"(acc[A][1][2][1]), "+v"(acc[A][1][3][0]), "+v"(acc[A][1][3][1]))
#define PIN_ACC() do { PIN_ACC_HALF(0); PIN_ACC_HALF(1); } while (0)
struct EpiUp {
    unsigned char* ws; int layer, rsel;
    __device__ __forceinline__ void operator()(f32x4 (&acc)[2][2][4][2], const Unit& u, int wr, int wc, int fr, int fq) const {
        { const int lane_ = (int)__builtin_amdgcn_mbcnt_hi(~0u, __builtin_amdgcn_mbcnt_lo(~0u, 0u)); fr = lane_ & 15; fq = lane_ >> 4; }
        asm volatile("" : "+v"(fr), "+v"(fq));
        const unsigned row0 = (unsigned)(u.pm * BM + wr * 64 + fr);
        typedef __attribute__((address_space(4))) const unsigned char* kap_t; const kap_t ka_ = (kap_t)__builtin_amdgcn_kernarg_segment_ptr();
        const float* cw = *(const float* const volatile __attribute__((address_space(4)))*)(ka_ + 8 * 19) + (size_t)layer * 3 * DFF2;
        const float* cb = *(const float* const volatile __attribute__((address_space(4)))*)(ka_ + 8 * 20) + (size_t)layer * DFF2;
        unsigned char* ldsx = g_lds + 132096;
        const char* rssb = (const char*)(ws + WS_RSS_OFF + (size_t)rsel * (16384u * 64u)); char* actb = (char*)(ws + WS_ACT_OFF); char* ebb = (char*)(ws + WS_EB_OFF);
        {
            float* rtab = (float*)(g_lds + 148480 + (wr * 4 + wc) * 512);
            const unsigned lrow = (unsigned)(u.pm * BM + wr * 64) + (unsigned)(fq * 16 + fr);
            rtab[fq * 16 + fr] = row_rinv((const float*)rssb, (int)lrow); rtab[64 + fq * 16 + fr] = row_rinv((const float*)rssb, (int)(lrow + HALF));
            asm volatile("s_waitcnt lgkmcnt(0)" ::: "memory");
#pragma unroll
            for (int ai = 0; ai < 2; ++ai)
#pragma unroll
                for (int m = 0; m < 4; ++m) { const float r = rtab[ai * 64 + m * 16 + fr];
#pragma unroll
                    for (int bj = 0; bj < 2; ++bj) { acc[ai][bj][m][0] *= r; acc[ai][bj][m][1] *= r; } } }
        PIN_ACC();
        unsigned char* sl = ldsx + (wr * 4 + wc) * 2048 + fr * 32 + fq * 8;
#pragma unroll
        for (int n = 0; n < 2; ++n) {
            const unsigned ch = (unsigned)(u.pn * 128 + wc * 32 + 8 * fq + 4 * n);
#pragma unroll
            for (int bj = 0; bj < 2; ++bj) {
                const char* cwb = (const char*)cw; const unsigned coff = (bj * DFF + ch) * 4u;
                const f32x4 w0 = *(const f32x4*)(cwb + coff), w1 = *(const f32x4*)(cwb + coff + DFF2 * 4u), w2 = *(const f32x4*)(cwb + coff + 2u * DFF2 * 4u), bb = *(const f32x4*)((const char*)cb + coff);
#pragma unroll
                for (int ai = 0; ai < 2; ++ai) {
                    const unsigned blk = (unsigned)(u.pm * 4 + ai * 2 + wr);
                    u32x2 pk[4];
#pragma unroll
                    for (int m = 0; m < 4; ++m) { const f32x4 x = acc[ai][bj][m][n]; pk[m].x = cvt_pk(x[0], x[1]); pk[m].y = cvt_pk(x[2], x[3]); *(u32x2*)(sl + m * 512) = pk[m]; }
                    { const unsigned dummy = 256u * 4u * DFF2 * 2u + (unsigned)(fq * 16 + fr) * 8u;
                      const unsigned e0 = fr < 2 ? ((blk * 4u + (unsigned)fr) * DFF2 + bj * DFF + ch) * 2u : dummy, e3 = fr >= 14 ? ((blk * 4u + (unsigned)(fr - 12)) * DFF2 + bj * DFF + ch) * 2u : dummy;
                      *(u32x2*)(ebb + e0) = pk[0]; *(u32x2*)(ebb + e3) = pk[3]; }
                    asm volatile("s_waitcnt lgkmcnt(0)" ::: "memory");
#pragma unroll
                    for (int m = 0; m < 4; ++m) { const f32x4 x = acc[ai][bj][m][n];
                        const u32x2 pw = *(const u32x2*)(sl + m * 512 - 32), nw = *(const u32x2*)(sl + m * 512 + 32);
                        const f32x4 pv = (f32x4){bflo(pw.x), bfhi(pw.x), bflo(pw.y), bfhi(pw.y)}, nv = (f32x4){bflo(nw.x), bfhi(nw.x), bflo(nw.y), bfhi(nw.y)};
                        acc[ai][bj][m][n] = pv * w0 + x * w1 + nv * w2 + bb; }
                    asm volatile("s_waitcnt lgkmcnt(0)" ::: "memory");
                    PIN_ACC();
                }
            }
        }
        {
            const unsigned ch0 = (unsigned)(u.pn * 128 + wc * 32 + 8 * fq);
#pragma unroll
            for (int ai = 0; ai < 2; ++ai)
#pragma unroll
                for (int m = 0; m < 4; ++m) { const unsigned row = row0 + ai * HALF + m * 16;
                    const f32x4 ca0 = acc[ai][0][m][0], cg0 = acc[ai][1][m][0], ca1 = acc[ai][0][m][1], cg1 = acc[ai][1][m][1];
                    u32x4 w;
                    w.x = cvt_pk(gelu_tanh_e(ca0[0]) * cg0[0], gelu_tanh_e(ca0[1]) * cg0[1]); w.y = cvt_pk(gelu_tanh_e(ca0[2]) * cg0[2], gelu_tanh_e(ca0[3]) * cg0[3]);
                    w.z = cvt_pk(gelu_tanh_e(ca1[0]) * cg1[0], gelu_tanh_e(ca1[1]) * cg1[1]); w.w = cvt_pk(gelu_tanh_e(ca1[2]) * cg1[2], gelu_tanh_e(ca1[3]) * cg1[3]);
                    __builtin_nontemporal_store(w, (u32x4*)(actb + (row * DFF + ch0) * 2u)); }
        }
    }
};
}

struct Params { const float* in[26]; float* out; unsigned char* ws; int lo, hi; };

__device__ __forceinline__ void transpose_item(const float* W, int K, int N, bf16_t* WT, int ldwt, int kdst, const float* gk, float sc_lo, int nlo, int nhi, float* scr, int item, int lane, bool permup = false) {
    const int nblk = N / 32, kb = item / nblk, nb = item % nblk, k0 = 64 * kb, n0 = 32 * nb;
    const float sc = (n0 >= nlo && n0 < nhi) ? sc_lo : 1.f;
#pragma unroll 8
    for (int i = 0; i < 32; ++i) { const int kk = 2 * i + (lane >> 5); float g = gk ? gk[k0 + kk] : 1.f; scr[kk * 33 + (lane & 31)] = W[(size_t)(k0 + kk) * N + n0 + (lane & 31)] * g * sc; }
    asm volatile("s_waitcnt lgkmcnt(0)" ::: "memory");
    const int c = lane & 7;
    int drow0 = n0; if (permup) { const int isg = n0 >= DFF ? 1 : 0, chn = n0 - isg * DFF; drow0 = (chn >> 7) * 256 + isg * 128 + (chn & 127); }
#pragma unroll
    for (int j = 0; j < 4; ++j) { const int n = (lane >> 3) + 8 * j; const float* s = scr + (8 * c) * 33 + n;
        u32x4 o; o.x = cvt_pk(s[0 * 33], s[1 * 33]); o.y = cvt_pk(s[2 * 33], s[3 * 33]); o.z = cvt_pk(s[4 * 33], s[5 * 33]); o.w = cvt_pk(s[6 * 33], s[7 * 33]);
        *(u32x4*)(WT + (size_t)(drow0 + n) * ldwt + kdst + k0 + 8 * c) = o; }
    asm volatile("s_waitcnt lgkmcnt(0)" ::: "memory");
}

typedef __attribute__((address_space(4))) const unsigned char* kaptr_t;
#define KIN0(i) (*(const float* const volatile __attribute__((address_space(4)))*)(ka + 8 * (i)))
__device__ __forceinline__ void phase0(const int TIDX, const int BIDX, const int GDIM, kaptr_t ka, unsigned char* lds) {
    const int tid = TIDX, lane = tid & 63, wave = tid >> 6;
    unsigned char* ws = *(unsigned char* const volatile __attribute__((address_space(4)))*)(ka + 8 * 27);
    const int gthreads = GDIM * 512, gtid = BIDX * 512 + tid;
    if (gtid < 128 * 16) { const int p = gtid >> 4, i = gtid & 15; const float invf = exp2f(-(float)i * (13.287712379549449f / 16.0f)); const float ang = (float)p * invf;
        ((f32x2*)(ws + WS_CS))[gtid] = (f32x2){cosf(ang), sinf(ang)}; }
    if (gtid >= 2048 && gtid < 2048 + 1024) { const int q = gtid - 2048, dir = q >> 9, ch = q & 511; const float* raw = KIN0(dir ? 9 : 8);
        float v[4], mx = -1e30f;
#pragma unroll
        for (int l = 0; l < 4; ++l) { v[l] = raw[l * 512 + ch]; mx = fmaxf(mx, v[l]); }
        float s = 0.f;
#pragma unroll
        for (int l = 0; l < 4; ++l) { v[l] = expf(v[l] - mx); s += v[l]; }
        float run = 0.f; float* LB = (float*)(ws + WS_LB);
#pragma unroll
        for (int l = 0; l < 4; ++l) { if (l > 0) run += v[l] / s; LB[(l * 2 + dir) * 512 + ch] = run; } }
    float* scr = (float*)(lds + wave * 16384);
    const int gw = BIDX * 8 + wave, NGW = GDIM * 8;
    constexpr int I_IN = 16 * 240, I_UP = 16 * 176, I_DN = 44 * 32, I_HG = 8 * 32, I_AT = 16 * 32, I_OUT = 16 * 32, I_PG = 16 * 32, I_PL = 4 * 32;
    constexpr int PER_L = I_IN + I_UP + I_DN + I_HG + I_AT + I_OUT + I_PG + I_PL;
    for (int it = gw; it < 4 * PER_L; it += NGW) {
        const int l = it / PER_L; int r = it % PER_L;
        if (r < I_IN) { transpose_item(KIN0(5) + (size_t)l * DM * INW, DM, INW, (bf16_t*)(ws + WS_WIN) + (size_t)l * INW * DM, DM, 0, KIN0(4) + l * DM, 0.08838834764831845f, OFF_HQ, OFF_HFF, scr, r, lane); continue; } r -= I_IN;
        if (r < I_UP) { transpose_item(KIN0(18) + (size_t)l * DM * DFF2, DM, DFF2, (bf16_t*)(ws + WS_WUP) + (size_t)l * DFF2 * DM, DM, 0, KIN0(17) + l * DM, 1.f, 0, 0, scr, r, lane, true); continue; } r -= I_UP;
        if (r < I_DN) { transpose_item(KIN0(21) + (size_t)l * DFF * DM, DFF, DM, (bf16_t*)(ws + WS_WDOWN) + (size_t)l * DM * DFF, DFF, 0, nullptr, 1.f, 0, 0, scr, r, lane); continue; } r -= I_DN;
        if (r < I_HG) { transpose_item(KIN0(14) + (size_t)l * 512 * DM, 512, DM, (bf16_t*)(ws + WS_WCAT) + (size_t)l * DM * YLD, YLD, 512, nullptr, 1.f, 0, 0, scr, r, lane); continue; } r -= I_HG;
        if (r < I_AT) { transpose_item(KIN0(15) + (size_t)l * DM * DM, DM, DM, (bf16_t*)(ws + WS_WCAT) + (size_t)l * DM * YLD, YLD, 1024, nullptr, 1.f, 0, 0, scr, r, lane); continue; } r -= I_AT;
        if (r < I_OUT) { transpose_item(KIN0(16) + (size_t)l * DM * DM, DM, DM, (bf16_t*)(ws + WS_WOUT) + (size_t)l * DM * DM, DM, 0, nullptr, 1.f, 0, 0, scr, r, lane); continue; } r -= I_OUT;
        if (r < I_PG) { transpose_item(KIN0(23) + (size_t)l * DM * DM, DM, DM, (bf16_t*)(ws + WS_WPG) + (size_t)l * DM * WPGLD, WPGLD, 0, KIN0(22) + l * DM, 1.f, 0, 0, scr, r, lane); continue; } r -= I_PG;
        transpose_item(KIN0(24) + (size_t)l * PLE * DM, PLE, DM, (bf16_t*)(ws + WS_WPG) + (size_t)l * DM * WPGLD, WPGLD, 1024, nullptr, 1.f, 0, 0, scr, r, lane);
    }
    for (int o = gtid; o < 4 * 512 * 1024; o += gthreads) {
        const int n = o & 1023, gc = (o >> 10) & 511, l = o >> 19, g = gc >> 7;
        const float* pw = KIN0(6) + ((size_t)l * 512 + gc) * 128; const float* sc = KIN0(7) + l * 512 + g * 128; const float* wb = KIN0(13) + ((size_t)l * 512 + g * 128) * DM + n;
        float s = 0.f;
#pragma unroll 8
        for (int d = 0; d < 128; ++d) s += pw[d] * sc[d] * wb[(size_t)d * DM];
        ((bf16_t*)(ws + WS_WCAT))[((size_t)l * DM + n) * YLD + gc] = f2bf(s);
    }
}

__device__ __forceinline__ void group_init(const int TIDX, const int BIDX, const int GDIM, const float* xin, bf16_t* xb, float* rss) {
    const int lane = TIDX & 63; const int gw = BIDX * 8 + (TIDX >> 6), NGW = GDIM * 8;
    for (int row = gw; row < T; row += NGW) {
        const f32x4* xr = (const f32x4*)(xin + (size_t)row * DM) + lane; float s = 0.f;
        f32x4 v[4];
#pragma unroll
        for (int j = 0; j < 4; ++j) { v[j] = xr[64 * j]; s += (v[j][0] * v[j][0] + v[j][1] * v[j][1]) + (v[j][2] * v[j][2] + v[j][3] * v[j][3]); }
        s = wave_sum(s);
#pragma unroll
        for (int j = 0; j < 4; ++j) { u32x2 w; w.x = cvt_pk(v[j][0], v[j][1]); w.y = cvt_pk(v[j][2], v[j][3]); *(u32x2*)(xb + (size_t)row * XBLD + 4 * lane + 256 * j) = w; }
        if (lane < 16) rss[(size_t)row * 16 + lane] = lane == 0 ? s : 0.f;
    }
}
__device__ __forceinline__ void final_norm(const int TIDX, const int BIDX, const int GDIM, float* out, const float* rss, const float* gfin) {
    const int lane = TIDX & 63; const int gw = BIDX * 8 + (TIDX >> 6), NGW = GDIM * 8;
    for (int row = gw; row < T; row += NGW) {
        const float r = pg8::row_rinv(rss, row);
        f32x4* xr = (f32x4*)(out + (size_t)row * DM) + lane; const f32x4* gp = (const f32x4*)gfin + lane;
#pragma unroll
        for (int j = 0; j < 4; ++j) { f32x4 v = xr[64 * j]; const f32x4 g = gp[64 * j]; v = v * r * g;
            xr[64 * j] = v; }
    }
}

__device__ __forceinline__ void prep_p(const int TIDX, const int BIDX, const int GDIM, const float* pin, bf16_t* xb) {
    const int lane = TIDX & 63; const int gw = BIDX * 8 + (TIDX >> 6), NGW = GDIM * 8;
    for (int row = gw; row < T; row += NGW) { const f32x4 v = ((const f32x4*)(pin + (size_t)row * PLE))[lane];
        u32x2 w; w.x = cvt_pk(v[0], v[1]); w.y = cvt_pk(v[2], v[3]); *(u32x2*)(xb + (size_t)row * XBLD + 1024 + 4 * lane) = w; }
}
__device__ __forceinline__ void prep_qk(const int TIDX, const int BIDX, const int GDIM, bf16_t* Z, const f32x2* cs, const float* gq, const float* gk, int N) {
    const int gthreads = GDIM * 512, gtid = BIDX * 512 + TIDX;
    for (int it = gtid; it < T * 40; it += gthreads) {
        const int a = it & 1, hv = (it >> 1) % 20, row = (it >> 1) / 20;
        const bool isq = hv < 16; const int coloff = isq ? OFF_AQ + hv * 64 : OFF_AK + (hv - 16) * 64;
        bf16_t* p = Z + (size_t)row * INW + coloff + a * 32;
        u32x4 w[4];
#pragma unroll
        for (int j = 0; j < 4; ++j) w[j] = ((const u32x4*)p)[j];
        float x[32];
#pragma unroll
        for (int j = 0; j < 4; ++j) { x[8 * j + 0] = bflo(w[j].x); x[8 * j + 1] = bfhi(w[j].x); x[8 * j + 2] = bflo(w[j].y); x[8 * j + 3] = bfhi(w[j].y);
            x[8 * j + 4] = bflo(w[j].z); x[8 * j + 5] = bfhi(w[j].z); x[8 * j + 6] = bflo(w[j].w); x[8 * j + 7] = bfhi(w[j].w); }
        float ss = 0.f;
#pragma unroll
        for (int d = 0; d < 32; ++d) ss += x[d] * x[d];
        ss += __shfl_xor(ss, 1);
        float r = rsqrtf(ss * (1.f / 64.f) + EPS); if (isq) r *= 0.125f * 1.4426950408889634f;
        const float* g = (isq ? gq : gk) + a * 32;
        const int t = row % N; const int pos = a == 0 ? (t >> 6) : (t & 63);
        const f32x2* c = cs + pos * 16;
        float y[32];
#pragma unroll
        for (int i = 0; i < 16; ++i) { const f32x2 cc = c[i]; const float x1 = x[i] * g[i], x2 = x[16 + i] * g[16 + i];
            y[i] = (x1 * cc.x - x2 * cc.y) * r; y[16 + i] = (x2 * cc.x + x1 * cc.y) * r; }
#pragma unroll
        for (int j = 0; j < 4; ++j) { u32x4 o; o.x = cvt_pk(y[8 * j], y[8 * j + 1]); o.y = cvt_pk(y[8 * j + 2], y[8 * j + 3]); o.z = cvt_pk(y[8 * j + 4], y[8 * j + 5]); o.w = cvt_pk(y[8 * j + 6], y[8 * j + 7]);
            ((u32x4*)p)[j] = o; }
    }
}
__device__ __forceinline__ void prep_vt(const int TIDX, const int BIDX, const int GDIM, const bf16_t* Z, bf16_t* VT, int N, unsigned char* lds) {
    const int tid = TIDX; bf16_t* Ts = (bf16_t*)lds;
    const int nc = N / 64;
    for (int it = BIDX; it < (T / 64) * 4; it += GDIM) {
        const int kvh = it & 3, cgl = it >> 2, seq = cgl / nc, c = cgl % nc;
        { const int t = tid >> 3, ch = tid & 7; const u32x4 v = *(const u32x4*)(Z + (size_t)(cgl * 64 + t) * INW + OFF_AV + kvh * 64 + ch * 8); *(u32x4*)(Ts + t * 72 + ch * 8) = v; }
        __syncthreads();
        { const int d = tid >> 3, ch = tid & 7; unsigned short e[8];
#pragma unroll
            for (int i = 0; i < 8; ++i) e[i] = Ts[(ch * 8 + i) * 72 + d];
            u32x4 o; o.x = e[0] | ((unsigned)e[1] << 16); o.y = e[2] | ((unsigned)e[3] << 16); o.z = e[4] | ((unsigned)e[5] << 16); o.w = e[6] | ((unsigned)e[7] << 16);
            *(u32x4*)(VT + (size_t)((seq * 4 + kvh) * 64 + d) * N + c * 64 + ch * 8) = o; }
        __syncthreads();
    }
}
template <int HALFW> __device__ __forceinline__ void pool_item(const bf16_t* Z, bf16_t* Y, int N, int row, int c8) {
    const int t = row % N;
    float s[8];
#pragma unroll
    for (int e = 0; e < 8; ++e) s[e] = 0.f;
    u32x4 w[2 * HALFW];
#pragma unroll
    for (int k = 0; k < 2 * HALFW; ++k) { const int q = t - HALFW + k; const bool ok = q >= 0 && q < N;
        w[k] = ok ? *(const u32x4*)(Z + (size_t)(row - HALFW + k) * INW + OFF_POOL + c8) : (u32x4){0u, 0u, 0u, 0u}; }
#pragma unroll
    for (int k = 0; k < 2 * HALFW; ++k) { s[0] += bflo(w[k].x); s[1] += bfhi(w[k].x); s[2] += bflo(w[k].y); s[3] += bfhi(w[k].y); s[4] += bflo(w[k].z); s[5] += bfhi(w[k].z); s[6] += bflo(w[k].w); s[7] += bfhi(w[k].w); }
    const int lo = t - HALFW < 0 ? 0 : t - HALFW, hi = t + HALFW > N ? N : t + HALFW;
    const float ic = frcp((float)(hi - lo));
    const u32x4 c = w[HALFW];
    const float u[8] = {bflo(c.x), bfhi(c.x), bflo(c.y), bfhi(c.y), bflo(c.z), bfhi(c.z), bflo(c.w), bfhi(c.w)};
    u32x4 o; o.x = cvt_pk(s[0] * ic - u[0], s[1] * ic - u[1]); o.y = cvt_pk(s[2] * ic - u[2], s[3] * ic - u[3]); o.z = cvt_pk(s[4] * ic - u[4], s[5] * ic - u[5]); o.w = cvt_pk(s[6] * ic - u[6], s[7] * ic - u[7]);
    *(u32x4*)(Y + (size_t)row * YLD + c8) = o;
}
__device__ __forceinline__ void prep_pool(const int TIDX, const int BIDX, const int GDIM, const bf16_t* Z, bf16_t* Y, int N) {
    const int gthreads = GDIM * 512, gtid = BIDX * 512 + TIDX;
    for (int it = gtid; it < T * 64; it += gthreads) {
        const int g = it / (T * 16), rem = it % (T * 16), row = rem >> 4, c8 = g * 128 + (rem & 15) * 8;
        if (g == 0) pool_item<1>(Z, Y, N, row, c8); else if (g == 1) pool_item<2>(Z, Y, N, row, c8); else if (g == 2) pool_item<4>(Z, Y, N, row, c8); else pool_item<8>(Z, Y, N, row, c8);
    }
}

__device__ __forceinline__ void hg_pass1(const int TIDX, const int BIDX, const int GDIM, const bf16_t* Z, bf16_t* ST, float* DEC, const float* LBl  , int N, unsigned char* lds) {
    const int tid = TIDX, lane = tid & 63, wid = tid >> 6, r32 = lane & 31, hi = lane >> 5;
    const int ch = tid & 127, qq = tid >> 7, nc = N / 64;
    bf16_t* Ktf = (bf16_t*)lds;
    bf16_t* Ktb = (bf16_t*)(lds + 18432);
    bf16_t* Vt = (bf16_t*)(lds + 36864);
    float* qtot = (float*)(lds + 55296);
    for (int u = BIDX; u < (T / 64) * 4; u += GDIM) {
        const int h = u & 3, cgl = u >> 2, seq = cgl / nc, c = cgl % nc, r0 = cgl * 64;
        const float lbf = LBl[h * 128 + ch], lbb = LBl[512 + h * 128 + ch];
        const bf16_t* zf = Z + (size_t)(r0 + qq * 16) * INW + OFF_HFF + h * 128 + ch;
        const bf16_t* zb = Z + (size_t)(r0 + qq * 16) * INW + OFF_HFB + h * 128 + ch;
        const bf16_t* zv = Z + (size_t)(r0 + qq * 16) * INW + OFF_HI + h * 128 + ch;
        float kf[16], pf[16], lb_[16], kb[16], pb[16]; unsigned short vv[16];
        float runf = 0.f, runb = 0.f;
#pragma unroll
        for (int i = 0; i < 16; ++i) {
            { const float z = bf2f(zf[(size_t)i * INW]); const float e = __expf(-z), sg = frcp(1.f + e); kf[i] = (1.f - lbf) * e * sg; runf += __logf(lbf + (1.f - lbf) * sg); pf[i] = runf; }
            { const float z = bf2f(zb[(size_t)i * INW]); const float e = __expf(-z), sg = frcp(1.f + e); kb[i] = (1.f - lbb) * e * sg; lb_[i] = __logf(lbb + (1.f - lbb) * sg); runb += lb_[i]; pb[i] = runb; }
            vv[i] = zv[(size_t)i * INW]; }
        qtot[qq * 128 + ch] = runf; qtot[512 + qq * 128 + ch] = runb;
        __syncthreads();
        const float f0 = qtot[ch], f1 = qtot[128 + ch], f2 = qtot[256 + ch], f3 = qtot[384 + ch];
        const float b0 = qtot[512 + ch], b1 = qtot[640 + ch], b2 = qtot[768 + ch], b3 = qtot[896 + ch];
        const float totf = (f0 + f1) + (f2 + f3), totb = (b0 + b1) + (b2 + b3);
        const float beff = (qq > 0 ? f0 : 0.f) + (qq > 1 ? f1 : 0.f) + (qq > 2 ? f2 : 0.f);
        const float befb = (qq > 0 ? b0 : 0.f) + (qq > 1 ? b1 : 0.f) + (qq > 2 ? b2 : 0.f);
        unsigned pkf[8], pkb[8];
#pragma unroll
        for (int i = 0; i < 16; i += 2) {
            pkf[i >> 1] = cvt_pk(kf[i] * __expf(totf - (beff + pf[i])), kf[i + 1] * __expf(totf - (beff + pf[i + 1])));
            pkb[i >> 1] = cvt_pk(kb[i] * __expf(befb + pb[i] - lb_[i]), kb[i + 1] * __expf(befb + pb[i + 1] - lb_[i + 1])); }
        *(u32x4*)(Ktf + ch * 72 + qq * 16) = (u32x4){pkf[0], pkf[1], pkf[2], pkf[3]}; *(u32x4*)(Ktf + ch * 72 + qq * 16 + 8) = (u32x4){pkf[4], pkf[5], pkf[6], pkf[7]};
        *(u32x4*)(Ktb + ch * 72 + qq * 16) = (u32x4){pkb[0], pkb[1], pkb[2], pkb[3]}; *(u32x4*)(Ktb + ch * 72 + qq * 16 + 8) = (u32x4){pkb[4], pkb[5], pkb[6], pkb[7]};
        *(u32x4*)(Vt + ch * 72 + qq * 16) = (u32x4){vv[0] | ((unsigned)vv[1] << 16), vv[2] | ((unsigned)vv[3] << 16), vv[4] | ((unsigned)vv[5] << 16), vv[6] | ((unsigned)vv[7] << 16)};
        *(u32x4*)(Vt + ch * 72 + qq * 16 + 8) = (u32x4){vv[8] | ((unsigned)vv[9] << 16), vv[10] | ((unsigned)vv[11] << 16), vv[12] | ((unsigned)vv[13] << 16), vv[14] | ((unsigned)vv[15] << 16)};
        const int sidxf = ((seq * 4 + h) * 2 + 0) * nc + c, sidxb = ((seq * 4 + h) * 2 + 1) * nc + c;
        if (tid < 128) { DEC[(size_t)sidxf * 128 + tid] = __expf(totf); DEC[(size_t)sidxb * 128 + tid] = __expf(totb); }
        __syncthreads();
        const int ti = wid >> 1;
#pragma unroll
        for (int dir = 0; dir < 2; ++dir) { const bf16_t* Kt = dir ? Ktb : Ktf; bf16_t* Sb = ST + (size_t)(dir ? sidxb : sidxf) * 16384;
#pragma unroll
            for (int jj = 0; jj < 2; ++jj) { const int tj = 2 * (wid & 1) + jj; f32x16 acc = {};
#pragma unroll
                for (int s = 0; s < 4; ++s) { const bf16x8 X = *(const bf16x8*)(Kt + (32 * ti + r32) * 72 + 16 * s + 8 * hi); const bf16x8 Y = *(const bf16x8*)(Vt + (32 * tj + r32) * 72 + 16 * s + 8 * hi); acc = mfma32(X, Y, acc); }
#pragma unroll
                for (int rg = 0; rg < 4; ++rg) { u32x2 w; w.x = cvt_pk(acc[4 * rg], acc[4 * rg + 1]); w.y = cvt_pk(acc[4 * rg + 2], acc[4 * rg + 3]);
                    *(u32x2*)(Sb + (32 * tj + r32) * 128 + 32 * ti + 8 * rg + 4 * hi) = w; } } }
        __syncthreads();
    }
}
__device__ __forceinline__ void hg_scan(const int TIDX, const int BIDX, const int GDIM, bf16_t* ST, const float* DEC, int N) {
    const int nc = N / 64, nchains = (T / N) * 8; const int total = nchains * 8192;
    for (int idx = BIDX * 512 + TIDX; idx < total; idx += GDIM * 512) {
        const int chain = idx >> 13, e2 = idx & 8191, dir = chain & 1, cho = (e2 * 2) & 127;
        float s0 = 0.f, s1 = 0.f;
        for (int st = 0; st < nc; st += 8) {
            unsigned uu[8]; f32x2 dd[8];
#pragma unroll
            for (int k = 0; k < 8; ++k) { const int c = dir ? nc - 1 - (st + k) : st + k; const size_t si = (size_t)chain * nc + c;
                uu[k] = *(const unsigned*)(ST + si * 16384 + e2 * 2); dd[k] = *(const f32x2*)(DEC + si * 128 + cho); }
#pragma unroll
            for (int k = 0; k < 8; ++k) { const int c = dir ? nc - 1 - (st + k) : st + k; const size_t si = (size_t)chain * nc + c;
                *(unsigned*)(ST + si * 16384 + e2 * 2) = cvt_pk(s0, s1);
                s0 = dd[k][0] * s0 + bflo(uu[k]); s1 = dd[k][1] * s1 + bfhi(uu[k]); }
        }
    }
}
__device__ __forceinline__ void hg_pass3(const int TIDX, const int BIDX, const int GDIM, const bf16_t* Z, const bf16_t* ST, bf16_t* Y, const float* LBl, const float* onorm, int N, unsigned char* lds) {
    const int tid = TIDX, lane = tid & 63, wid = tid >> 6, r32 = lane & 31, hi = lane >> 5;
    const int ch = tid & 127, qq = tid >> 7, nc = N / 64;
    bf16_t* Qt = (bf16_t*)lds;
    bf16_t* Kt = (bf16_t*)(lds + 17408);
    bf16_t* Qh = (bf16_t*)(lds + 34816);
    bf16_t* Vt = (bf16_t*)(lds + 52224);
    float* qtot = (float*)(lds + 70656);
    float* ssq = (float*)(lds + 72704);
    const int dt = wid >> 1, jt = wid & 1;
    for (int u = BIDX; u < (T / 64) * 4; u += GDIM) {
        const int h = u & 3, cgl = u >> 2, seq = cgl / nc, c = cgl % nc, r0 = cgl * 64;
        f32x16 o = {};
        { const bf16_t* zv = Z + (size_t)(r0 + qq * 16) * INW + OFF_HI + h * 128 + ch; unsigned short vv[16];
#pragma unroll
            for (int i = 0; i < 16; ++i) vv[i] = zv[(size_t)i * INW];
            *(u32x4*)(Vt + ch * 72 + qq * 16) = (u32x4){vv[0] | ((unsigned)vv[1] << 16), vv[2] | ((unsigned)vv[3] << 16), vv[4] | ((unsigned)vv[5] << 16), vv[6] | ((unsigned)vv[7] << 16)};
            *(u32x4*)(Vt + ch * 72 + qq * 16 + 8) = (u32x4){vv[8] | ((unsigned)vv[9] << 16), vv[10] | ((unsigned)vv[11] << 16), vv[12] | ((unsigned)vv[13] << 16), vv[14] | ((unsigned)vv[15] << 16)}; }
#pragma unroll 1
        for (int dir = 0; dir < 2; ++dir) {
            const float lb = LBl[dir * 512 + h * 128 + ch];
            const bf16_t* zf = Z + (size_t)(r0 + qq * 16) * INW + (dir ? OFF_HFB : OFF_HFF) + h * 128 + ch;
            const bf16_t* zq = Z + (size_t)(r0 + qq * 16) * INW + OFF_HQ + h * 128 + ch;
            float lf[16], kk[16], pre[16], qv[16]; float run = 0.f;
#pragma unroll
            for (int i = 0; i < 16; ++i) { const float z = bf2f(zf[(size_t)i * INW]); const float e = __expf(-z), sg = frcp(1.f + e);
                lf[i] = __logf(lb + (1.f - lb) * sg); kk[i] = (1.f - lb) * e * sg; run += lf[i]; pre[i] = run; qv[i] = bf2f(zq[(size_t)i * INW]); }
            qtot[qq * 128 + ch] = run;
            __syncthreads();
            const float t0 = qtot[ch], t1 = qtot[128 + ch], t2 = qtot[256 + ch], t3 = qtot[384 + ch];
            const float before = (qq > 0 ? t0 : 0.f) + (qq > 1 ? t1 : 0.f) + (qq > 2 ? t2 : 0.f);
            const float after = (qq < 1 ? t1 : 0.f) + (qq < 2 ? t2 : 0.f) + (qq < 3 ? t3 : 0.f);
            const float ref = dir == 0 ? (t0 + t1) : (t2 + t3);
#pragma unroll
            for (int i = 0; i < 16; ++i) {
                const float cum = dir == 0 ? before + pre[i] : after + (run - pre[i] + lf[i]);
                const float d = cum - ref; const int p = qq * 16 + i;
                Qt[p * 136 + ch] = f2bf(qv[i] * __expf(d)); Kt[p * 136 + ch] = f2bf(kk[i] * __expf(-d)); Qh[p * 136 + ch] = f2bf(qv[i] * __expf(cum)); }
            __syncthreads();
            f32x16 a0 = {}, a1 = {};
#pragma unroll
            for (int s = 0; s < 8; ++s) { const bf16x8 Yq = *(const bf16x8*)(Qt + (32 * jt + r32) * 136 + 16 * s + 8 * hi);
                const bf16x8 X0 = *(const bf16x8*)(Kt + r32 * 136 + 16 * s + 8 * hi); const bf16x8 X1 = *(const bf16x8*)(Kt + (32 + r32) * 136 + 16 * s + 8 * hi);
                a0 = mfma32(X0, Yq, a0); a1 = mfma32(X1, Yq, a1); }
            const int j = 32 * jt + r32;
#pragma unroll
            for (int r = 0; r < 16; ++r) { const int l0 = crow(r, hi), l1 = 32 + l0;
                const bool k0 = dir == 0 ? (l0 <= j) : (l0 >= j), k1 = dir == 0 ? (l1 <= j) : (l1 >= j);
                a0[r] = k0 ? a0[r] : 0.f; a1[r] = k1 ? a1[r] : 0.f; }
            bf16x8 pa[2][2];
#pragma unroll
            for (int u2 = 0; u2 < 2; ++u2) { u32x4 w0, w1;
                w0.x = cvt_pk(a0[8 * u2], a0[8 * u2 + 1]); w0.y = cvt_pk(a0[8 * u2 + 2], a0[8 * u2 + 3]); w0.z = cvt_pk(a0[8 * u2 + 4], a0[8 * u2 + 5]); w0.w = cvt_pk(a0[8 * u2 + 6], a0[8 * u2 + 7]);
                w1.x = cvt_pk(a1[8 * u2], a1[8 * u2 + 1]); w1.y = cvt_pk(a1[8 * u2 + 2], a1[8 * u2 + 3]); w1.z = cvt_pk(a1[8 * u2 + 4], a1[8 * u2 + 5]); w1.w = cvt_pk(a1[8 * u2 + 6], a1[8 * u2 + 7]);
                pa[0][u2] = __builtin_bit_cast(bf16x8, w0); pa[1][u2] = __builtin_bit_cast(bf16x8, w1); }
#pragma unroll
            for (int lt = 0; lt < 2; ++lt)
#pragma unroll
                for (int u2 = 0; u2 < 2; ++u2) { const int base = 32 * lt + 16 * u2;
                    const s16x4 vlo = *(const s16x4*)(Vt + (32 * dt + r32) * 72 + base + 4 * hi); const s16x4 vhi = *(const s16x4*)(Vt + (32 * dt + r32) * 72 + base + 8 + 4 * hi);
                    const bf16x8 X = (bf16x8){vlo[0], vlo[1], vlo[2], vlo[3], vhi[0], vhi[1], vhi[2], vhi[3]};
                    o = mfma32(X, pa[lt][u2], o); }
            const int sidx = ((seq * 4 + h) * 2 + dir) * nc + c;
            const bf16_t* Sb = ST + (size_t)sidx * 16384 + (32 * dt + r32) * 128 + 8 * hi;
#pragma unroll
            for (int s = 0; s < 8; ++s) { const bf16x8 X = *(const bf16x8*)(Sb + 16 * s); const bf16x8 Yq = *(const bf16x8*)(Qh + (32 * jt + r32) * 136 + 16 * s + 8 * hi); o = mfma32(X, Yq, o); }
            __syncthreads();
        }
        float ss = 0.f;
#pragma unroll
        for (int r = 0; r < 16; ++r) ss += o[r] * o[r];
        ss += __shfl_xor(ss, 32);
        if (hi == 0) ssq[dt * 64 + 32 * jt + r32] = ss;
        __syncthreads();
        const int j = 32 * jt + r32;
        const float rinv = rsqrtf(((ssq[j] + ssq[64 + j]) + (ssq[128 + j] + ssq[192 + j])) * (1.f / 128.f) + EPS);
#pragma unroll
        for (int rg = 0; rg < 4; ++rg) { const int dv = 32 * dt + 8 * rg + 4 * hi;
            const u32x2 gw = *(const u32x2*)(Z + (size_t)(r0 + j) * INW + OFF_HG + h * 128 + dv); const f32x4 gn = *(const f32x4*)(onorm + dv);
            const float g0 = bflo(gw.x), g1 = bfhi(gw.x), g2 = bflo(gw.y), g3 = bfhi(gw.y);
            const float y0 = o[4 * rg] * rinv * gn[0] * g0 * sigm(g0), y1 = o[4 * rg + 1] * rinv * gn[1] * g1 * sigm(g1), y2 = o[4 * rg + 2] * rinv * gn[2] * g2 * sigm(g2), y3 = o[4 * rg + 3] * rinv * gn[3] * g3 * sigm(g3);
            u32x2 w; w.x = cvt_pk(y0, y1); w.y = cvt_pk(y2, y3);
            *(u32x2*)(Y + (size_t)(r0 + j) * YLD + 512 + h * 128 + dv) = w; }
        __syncthreads();
    }
}

#define ATT_PACK(P0, P1, PA) do { _Pragma("unroll") for (int u2 = 0; u2 < 2; ++u2) { u32x4 w0, w1; \
    w0.x = cvt_pk(P0[8 * u2], P0[8 * u2 + 1]); w0.y = cvt_pk(P0[8 * u2 + 2], P0[8 * u2 + 3]); w0.z = cvt_pk(P0[8 * u2 + 4], P0[8 * u2 + 5]); w0.w = cvt_pk(P0[8 * u2 + 6], P0[8 * u2 + 7]); \
    w1.x = cvt_pk(P1[8 * u2], P1[8 * u2 + 1]); w1.y = cvt_pk(P1[8 * u2 + 2], P1[8 * u2 + 3]); w1.z = cvt_pk(P1[8 * u2 + 4], P1[8 * u2 + 5]); w1.w = cvt_pk(P1[8 * u2 + 6], P1[8 * u2 + 7]); \
    PA[0][u2] = __builtin_bit_cast(bf16x8, w0); PA[1][u2] = __builtin_bit_cast(bf16x8, w1); } } while (0)
#define ATT_SOFTMAX(P0, P1, LR) do { \
    float ps = 0.f; _Pragma("unroll") for (int r = 0; r < 16; ++r) { P0[r] = __builtin_amdgcn_exp2f(P0[r]); P1[r] = __builtin_amdgcn_exp2f(P1[r]); ps += P0[r] + P1[r]; } \
    LR += ps; } while (0)
__device__ __forceinline__ void attn_phase(const int TIDX, const int BIDX, const int GDIM, const bf16_t* Z, const bf16_t* VT, bf16_t* Y, const float* gq, const float* gk, int N, unsigned char* lds) {
    const int tid = TIDX, lane = tid & 63, wid = tid >> 6, r32 = lane & 31, hi = lane >> 5;
    const int nq = N / 128, NT = N / 64;
    const int srow = tid >> 3, sch = tid & 7;
    float negshift;
    { float a = fabsf(gq[lane]), b = fabsf(gk[lane]);
#pragma unroll
      for (int o = 1; o < 64; o <<= 1) { a = fmaxf(a, __shfl_xor(a, o)); b = fmaxf(b, __shfl_xor(b, o)); }
      negshift = __uint_as_float(__builtin_amdgcn_readfirstlane(__float_as_uint(-fmaxf(11.5416f * a * b * 1.02f - 24.0f, 0.f)))); }
    const int vcu = (GDIM % 8 == 0) ? (BIDX % 8) * (GDIM / 8) + BIDX / 8 : BIDX;
    const int NU = (T / 128) * 4, upc = (NU + GDIM - 1) / GDIM;
    for (int ui = 0; ui < upc; ++ui) {
        const int u = vcu * upc + ui; if (u >= NU) break;
        const int qblk = u % nq, sk = u / nq, kvh = sk & 3, seq = sk >> 2;
        const int seqrow0 = seq * N;
        const int head = kvh * 4 + (wid >> 1); const int qrowA = seqrow0 + qblk * 128 + 64 * (wid & 1) + r32, qrowB = qrowA + 32;
        bf16x8 qa[4], qb[4];
        { const bf16_t* qp = Z + (size_t)qrowA * INW + OFF_AQ + head * 64 + hi * 8;
#pragma unroll
            for (int d0 = 0; d0 < 4; ++d0) { qa[d0] = *(const bf16x8*)(qp + d0 * 16); qb[d0] = *(const bf16x8*)(qp + (size_t)32 * INW + d0 * 16); } }
        const bf16_t* kg = Z + (size_t)(seqrow0 + srow) * INW + OFF_AK + kvh * 64 + sch * 8;
        const bf16_t* vg = VT + (size_t)((seq * 4 + kvh) * 64 + srow) * N + sch * 8;
        u32x4 kreg = *(const u32x4*)kg, vreg = *(const u32x4*)vg;
        *(u32x4*)(lds + srow * 144 + sch * 16) = kreg; *(u32x4*)(lds + 18432 + srow * 144 + sch * 16) = vreg;
        __syncthreads();
        float lA = 0.f, lB = 0.f; f32x16 oA0 = {}, oA1 = {}, oB0 = {}, oB1 = {};
        for (int t = 0; t < NT; ++t) {
            const int buf = t & 1;
            if (t + 1 < NT) { kreg = *(const u32x4*)(kg + (size_t)(t + 1) * 64 * INW); vreg = *(const u32x4*)(vg + (size_t)(t + 1) * 64); }
            const unsigned char* Ks = lds + buf * 9216; const unsigned char* Vs = lds + 18432 + buf * 9216;
            f32x16 pA0 = {}, pA1 = {}, pB0 = {}, pB1 = {};
#pragma unroll
            for (int d0 = 0; d0 < 4; ++d0) { const bf16x8 k0 = *(const bf16x8*)(Ks + r32 * 144 + (d0 * 16 + hi * 8) * 2); const bf16x8 k1 = *(const bf16x8*)(Ks + (32 + r32) * 144 + (d0 * 16 + hi * 8) * 2);
                pA0 = mfma32(k0, qa[d0], pA0); pA1 = mfma32(k1, qa[d0], pA1); pB0 = mfma32(k0, qb[d0], pB0); pB1 = mfma32(k1, qb[d0], pB1); }
            bf16x8 paA[2][2], paB[2][2];
            if (negshift != 0.f) {
#pragma unroll
                for (int r = 0; r < 16; ++r) { pA0[r] += negshift; pA1[r] += negshift; pB0[r] += negshift; pB1[r] += negshift; } }
            ATT_SOFTMAX(pA0, pA1, lA); ATT_PACK(pA0, pA1, paA);
            ATT_SOFTMAX(pB0, pB1, lB); ATT_PACK(pB0, pB1, paB);
#pragma unroll
            for (int hh = 0; hh < 2; ++hh)
#pragma unroll
                for (int u2 = 0; u2 < 2; ++u2) { const int base = 32 * hh + 16 * u2;
                    { const s16x4 vlo = *(const s16x4*)(Vs + r32 * 144 + (base + 4 * hi) * 2); const s16x4 vhi = *(const s16x4*)(Vs + r32 * 144 + (base + 8 + 4 * hi) * 2);
                      const bf16x8 vf = (bf16x8){vlo[0], vlo[1], vlo[2], vlo[3], vhi[0], vhi[1], vhi[2], vhi[3]};
                      oA0 = mfma32(vf, paA[hh][u2], oA0); oB0 = mfma32(vf, paB[hh][u2], oB0); }
                    { const s16x4 vlo = *(const s16x4*)(Vs + (32 + r32) * 144 + (base + 4 * hi) * 2); const s16x4 vhi = *(const s16x4*)(Vs + (32 + r32) * 144 + (base + 8 + 4 * hi) * 2);
                      const bf16x8 vf = (bf16x8){vlo[0], vlo[1], vlo[2], vlo[3], vhi[0], vhi[1], vhi[2], vhi[3]};
                      oA1 = mfma32(vf, paA[hh][u2], oA1); oB1 = mfma32(vf, paB[hh][u2], oB1); } }
            if (t + 1 < NT) { *(u32x4*)(lds + (buf ^ 1) * 9216 + srow * 144 + sch * 16) = kreg; *(u32x4*)(lds + 18432 + (buf ^ 1) * 9216 + srow * 144 + sch * 16) = vreg; }
            __syncthreads();
        }
        lA += __shfl_xor(lA, 32); lB += __shfl_xor(lB, 32);
        const float invA = 1.f / lA, invB = 1.f / lB;
        bf16_t* ypA = Y + (size_t)qrowA * YLD + 1024 + head * 64; bf16_t* ypB = ypA + (size_t)32 * YLD;
#pragma unroll
        for (int rg = 0; rg < 4; ++rg) { const int d = 8 * rg + 4 * hi; u32x2 w;
            w.x = cvt_pk(oA0[4 * rg] * invA, oA0[4 * rg + 1] * invA); w.y = cvt_pk(oA0[4 * rg + 2] * invA, oA0[4 * rg + 3] * invA); *(u32x2*)(ypA + d) = w;
            w.x = cvt_pk(oA1[4 * rg] * invA, oA1[4 * rg + 1] * invA); w.y = cvt_pk(oA1[4 * rg + 2] * invA, oA1[4 * rg + 3] * invA); *(u32x2*)(ypA + 32 + d) = w;
            w.x = cvt_pk(oB0[4 * rg] * invB, oB0[4 * rg + 1] * invB); w.y = cvt_pk(oB0[4 * rg + 2] * invB, oB0[4 * rg + 3] * invB); *(u32x2*)(ypB + d) = w;
            w.x = cvt_pk(oB1[4 * rg] * invB, oB1[4 * rg + 1] * invB); w.y = cvt_pk(oB1[4 * rg + 2] * invB, oB1[4 * rg + 3] * invB); *(u32x2*)(ypB + 32 + d) = w; }
    }
}

__device__ __forceinline__ float gelu_tanh(float a) { const float e = __builtin_amdgcn_exp2f(a * (2.3022081984f + 0.1029432396f * (a * a))); return a - a * frcp(e + 1.f);   }
__device__ __forceinline__ void unpack8(const u32x4 w, float* x) { x[0] = bflo(w.x); x[1] = bfhi(w.x); x[2] = bflo(w.y); x[3] = bfhi(w.y); x[4] = bflo(w.z); x[5] = bfhi(w.z); x[6] = bflo(w.w); x[7] = bfhi(w.w); }
__device__ __forceinline__ void conv_act(const int TIDX, const int BIDX, const int GDIM, const bf16_t* U, bf16_t* ACT, const float* cw, const float* cb, int N) {
    const int gthreads = GDIM * 512, gtid = BIDX * 512 + TIDX;
    constexpr int NCG = DFF / 8;
    for (int it = gtid; it < (T / 16) * NCG; it += gthreads) {
        const int cg8 = it % NCG, run = it / NCG, row0 = run * 16, t0 = row0 % N, c0 = cg8 * 8;
        float wa[3][8], wg[3][8], ba[8], bg[8];
#pragma unroll
        for (int k = 0; k < 3; ++k)
#pragma unroll
            for (int e = 0; e < 8; ++e) { wa[k][e] = cw[k * DFF2 + c0 + e]; wg[k][e] = cw[k * DFF2 + DFF + c0 + e]; }
#pragma unroll
        for (int e = 0; e < 8; ++e) { ba[e] = cb[c0 + e]; bg[e] = cb[DFF + c0 + e]; }
        float pa[8], pg[8], ca[8], cgv[8], na[8], ng[8];
        const u32x4 zero = (u32x4){0u, 0u, 0u, 0u};
        { const u32x4 a = t0 > 0 ? *(const u32x4*)(U + (size_t)(row0 - 1) * DFF2 + c0) : zero; const u32x4 g = t0 > 0 ? *(const u32x4*)(U + (size_t)(row0 - 1) * DFF2 + DFF + c0) : zero; unpack8(a, pa); unpack8(g, pg); }
        { const u32x4 a = *(const u32x4*)(U + (size_t)row0 * DFF2 + c0); const u32x4 g = *(const u32x4*)(U + (size_t)row0 * DFF2 + DFF + c0); unpack8(a, ca); unpack8(g, cgv); }
#pragma unroll 4
        for (int i = 0; i < 16; ++i) { const int row = row0 + i; const bool hasn = (t0 + i + 1) < N;
            const u32x4 a = hasn ? *(const u32x4*)(U + (size_t)(row + 1) * DFF2 + c0) : zero; const u32x4 g = hasn ? *(const u32x4*)(U + (size_t)(row + 1) * DFF2 + DFF + c0) : zero; unpack8(a, na); unpack8(g, ng);
            float r[8];
#pragma unroll
            for (int e = 0; e < 8; ++e) { const float av = pa[e] * wa[0][e] + ca[e] * wa[1][e] + na[e] * wa[2][e] + ba[e]; const float gv = pg[e] * wg[0][e] + cgv[e] * wg[1][e] + ng[e] * wg[2][e] + bg[e]; r[e] = gelu_tanh(av) * gv; }
            u32x4 o; o.x = cvt_pk(r[0], r[1]); o.y = cvt_pk(r[2], r[3]); o.z = cvt_pk(r[4], r[5]); o.w = cvt_pk(r[6], r[7]);
            *(u32x4*)(ACT + (size_t)row * DFF + c0) = o;
#pragma unroll
            for (int e = 0; e < 8; ++e) { pa[e] = ca[e]; pg[e] = cgv[e]; ca[e] = na[e]; cgv[e] = ng[e]; } }
    }
}


constexpr size_t WS_BAR = 256 * 1024;
#define XB_TMO      128
#define XB_XCNT(j)  (256  + 64 * (j))
#define XB_XSUB(j)  (1280 + 64 * (j))
#define XB_XGEN(j)  (2304 + 64 * (j))
#define XB_TOP      3328
#define XB_TOPGEN   3392
#define XCD_BAR_WORDS 3456
#define XB_SPIN_CAP (1u << 22)
__device__ __forceinline__ unsigned xb_ld(unsigned* p)              { return __hip_atomic_load(p, __ATOMIC_RELAXED, __HIP_MEMORY_SCOPE_AGENT); }
__device__ __forceinline__ unsigned xb_add(unsigned* p, unsigned v) { return __hip_atomic_fetch_add(p, v, __ATOMIC_RELAXED, __HIP_MEMORY_SCOPE_AGENT); }
__device__ __forceinline__ unsigned xb_xcc_id() { return (unsigned)__builtin_amdgcn_s_getreg((3 << 11) | 20) & 0xFu; }
#define XB_SPIN(cond, bar) do { unsigned _sp = 0; while (cond) { __builtin_amdgcn_s_sleep(1); \
    if ((++_sp & 255u) == 0u) { if (xb_ld(&(bar)[XB_TMO])) break; if (_sp > XB_SPIN_CAP) { atomicAdd(&(bar)[XB_TMO], 1u); break; } } } } while (0)
struct XcdBarrier { unsigned* bar; unsigned x; volatile LAS unsigned* st; };
__device__ __forceinline__ XcdBarrier xcd_barrier_post(unsigned* bar, volatile LAS unsigned* st) {
    XcdBarrier b; b.bar = bar; b.x = xb_xcc_id(); b.st = st;
    if (threadIdx.x == 0) (void)xb_add(&bar[XB_XCNT(b.x)], 1u);
    return b;
}
__device__ __forceinline__ void xcd_barrier_complete(unsigned* bar, unsigned x, unsigned& nloc, unsigned& nx) {
    const unsigned G = gridDim.x * gridDim.y * gridDim.z;
    unsigned sum, cnt, mine, sp = 0u;
    for (;;) {
        sum = 0u; cnt = 0u; mine = 0u;
#pragma unroll
        for (unsigned j = 0; j < 16; ++j) { const unsigned c = xb_ld(&bar[XB_XCNT(j)]); sum += c; cnt += (c > 0u) ? 1u : 0u; mine = (j == x) ? c : mine; }
        if (sum == G) break;
        __builtin_amdgcn_s_sleep(1);
        if ((++sp & 255u) == 0u) { if (xb_ld(&bar[XB_TMO])) break; if (sp > XB_SPIN_CAP) { atomicAdd(&bar[XB_TMO], 1u); break; } }
    }
    nloc = mine > 0u ? mine : 1u; nx = cnt > 0u ? cnt : 1u;
}
__device__ __forceinline__ void xcd_barrier(const XcdBarrier& b) {
    asm volatile("s_waitcnt vmcnt(0)" ::: "memory");
    __syncthreads();
    if (threadIdx.x == 0) {
        unsigned* bar = b.bar;
        __builtin_amdgcn_s_waitcnt(0);
        unsigned nloc = b.st[0], nx = b.st[1];
        if (nloc == 0u) { xcd_barrier_complete(bar, b.x, nloc, nx); b.st[0] = nloc; b.st[1] = nx; }
        const unsigned old = xb_add(&bar[XB_XSUB(b.x)], 1u);
        const unsigned gen = old / nloc;
        if (old + 1u == (gen + 1u) * nloc) {
            __builtin_amdgcn_fence(__ATOMIC_RELEASE, "agent");
            asm volatile("s_waitcnt vmcnt(0)" ::: "memory");
            const unsigned og = xb_add(&bar[XB_TOP], 1u);
            const unsigned tg = og / nx;
            if (og + 1u == (tg + 1u) * nx) xb_add(&bar[XB_TOPGEN], 1u);
            else XB_SPIN(xb_ld(&bar[XB_TOPGEN]) == tg, bar);
            __builtin_amdgcn_fence(__ATOMIC_ACQUIRE, "agent");
            xb_add(&bar[XB_XGEN(b.x)], 1u);
            asm volatile("s_waitcnt vmcnt(0)" ::: "memory");
        } else {
            XB_SPIN(xb_ld(&bar[XB_XGEN(b.x)]) == gen, bar);
            __builtin_amdgcn_fence(__ATOMIC_ACQUIRE, "agent");
            asm volatile("s_waitcnt vmcnt(0)" ::: "memory");
        }
    }
    __syncthreads();
}

__device__ __forceinline__ void conv_fix(const int TIDX, const int BIDX, const int GDIM, const bf16_t* EB, bf16_t* ACT, const float* cw, const float* cb, int N) {
    const int gthreads = GDIM * 512, gtid = BIDX * 512 + TIDX;
    constexpr int NCG = DFF / 8;
    for (int it = gtid; it < (T / 64) * 2 * NCG; it += gthreads) {
        const int cg8 = it % NCG, be = it / NCG, edge = be & 1, blk = be >> 1, c0 = cg8 * 8;
        const int row = blk * 64 + (edge ? 63 : 0), t = row % N;
        const bf16_t* pP = edge ? EB + ((size_t)blk * 4 + 2) * DFF2 : EB + ((size_t)(blk - 1) * 4 + 3) * DFF2;
        const bf16_t* pC = EB + ((size_t)blk * 4 + (edge ? 3 : 0)) * DFF2;
        const bf16_t* pN = edge ? EB + ((size_t)(blk + 1) * 4 + 0) * DFF2 : EB + ((size_t)blk * 4 + 1) * DFF2;
        const bool hasp = t > 0, hasn = t + 1 < N;
        const u32x4 zero = (u32x4){0u, 0u, 0u, 0u};
        float pa[8], pg[8], ca[8], cg[8], na[8], ng[8];
        unpack8(hasp ? *(const u32x4*)(pP + c0) : zero, pa); unpack8(hasp ? *(const u32x4*)(pP + DFF + c0) : zero, pg);
        unpack8(*(const u32x4*)(pC + c0), ca); unpack8(*(const u32x4*)(pC + DFF + c0), cg);
        unpack8(hasn ? *(const u32x4*)(pN + c0) : zero, na); unpack8(hasn ? *(const u32x4*)(pN + DFF + c0) : zero, ng);
        float r[8];
#pragma unroll
        for (int e = 0; e < 8; ++e) { const float av = pa[e] * cw[c0 + e] + ca[e] * cw[DFF2 + c0 + e] + na[e] * cw[2 * DFF2 + c0 + e] + cb[c0 + e];
            const float gv = pg[e] * cw[DFF + c0 + e] + cg[e] * cw[DFF2 + DFF + c0 + e] + ng[e] * cw[2 * DFF2 + DFF + c0 + e] + cb[DFF + c0 + e]; r[e] = gelu_tanh(av) * gv; }
        u32x4 o; o.x = cvt_pk(r[0], r[1]); o.y = cvt_pk(r[2], r[3]); o.z = cvt_pk(r[4], r[5]); o.w = cvt_pk(r[6], r[7]);
        *(u32x4*)(ACT + (size_t)row * DFF + c0) = o;
    }
}

constexpr int STEPS_PER_GROUP = 42, NSTEPS = 1 + NGROUP * STEPS_PER_GROUP;

__global__ void __launch_bounds__(512, 2) mega(Params P) {
    extern __shared__ __attribute__((aligned(16))) unsigned char lds[];
    LAS unsigned char* lds3 = (LAS unsigned char*)lds;
    typedef __attribute__((address_space(4))) const unsigned char* kaptr_t;
    const kaptr_t ka = (kaptr_t)__builtin_amdgcn_kernarg_segment_ptr();
#define KIN(i) (*(const float* const volatile __attribute__((address_space(4)))*)(ka + 8 * (i)))
#define KOUT (*(float* const volatile __attribute__((address_space(4)))*)(ka + 8 * 26))
#define KWS (*(unsigned char* const volatile __attribute__((address_space(4)))*)(ka + 8 * 27))
#define KLO (*(const volatile int __attribute__((address_space(4)))*)(ka + 8 * 28))
#define KHI (*(const volatile int __attribute__((address_space(4)))*)(ka + 8 * 28 + 4))
    const int step_hi = KHI;
    volatile LAS unsigned* MISC = (volatile LAS unsigned*)(lds3 + 131072 + 320);
    if (threadIdx.x < 32) MISC[threadIdx.x] = 0u;
    __syncthreads();
    XcdBarrier gbar = xcd_barrier_post((unsigned*)(KWS + WS_BAR), MISC + 8);
    bool first_sync = true;
    for (int step = KLO; step < step_hi; ++step) {
        unsigned char* ws = KWS;
        int tid_o = threadIdx.x, bx_o = blockIdx.x, G_o = gridDim.x;
        asm volatile("" : "+v"(tid_o)); asm volatile("" : "+s"(bx_o)); asm volatile("" : "+s"(G_o));
        const int G = G_o, bx = bx_o;
        if (step == 0) { phase0(tid_o, bx_o, G_o, ka, lds); }
        else {
            const int g = (step - 1) / STEPS_PER_GROUP, s = (step - 1) % STEPS_PER_GROUP;
            const int N = g == 0 ? 4096 : 8192;
            const float* xin = g == 0 ? KIN(0) : KIN(1) + (size_t)(g - 1) * T * DM;
            float* xout = KOUT + (size_t)g * T * DM;
            bf16_t* XB0 = (bf16_t*)(ws + WS_XB0); bf16_t* XB1 = (bf16_t*)(ws + WS_XB1);
            float* RSS0 = (float*)(ws + WS_RSS); float* RSS1 = RSS0 + (size_t)T * 16;
            bf16_t* Z = (bf16_t*)(ws + WS_Z); bf16_t* YC = (bf16_t*)(ws + WS_YCAT); bf16_t* MG = (bf16_t*)(ws + WS_MERGED);
            bf16_t* ST = (bf16_t*)(ws + WS_ST); bf16_t* FACC = (bf16_t*)(ws + WS_ST); bf16_t* VT = (bf16_t*)(ws + WS_VT); float* DEC = (float*)(ws + WS_DEC);
            bf16_t* ACT = YC; bf16_t* EB = (bf16_t*)(ws + WS_ST + 32 * MiB);
            if (s == 0) group_init(tid_o, bx_o, G_o, xin, XB0, RSS0);
            else if (s == 41) final_norm(tid_o, bx_o, G_o, xout, RSS0, KIN(25));
            else {
                const int layer = (s - 1) / 10, ls = (s - 1) % 10, cur = layer & 1;
                bf16_t* XBc = cur ? XB1 : XB0; bf16_t* XBn = cur ? XB0 : XB1;
                float* RSSc = cur ? RSS1 : RSS0; float* RSSn = cur ? RSS0 : RSS1;
                const float* LBl = (const float*)(ws + WS_LB) + layer * 1024;
                const float* xbase = layer == 0 ? xin : xout;
                if (ls == 0) {
                    pg8::Gemm gm{XBc, (const bf16_t*)(ws + WS_WIN) + (size_t)layer * INW * DM, XBLD, DM};
                    pg8::Sched<INW, 1, 0, 16, 0, 0, 0, 0> S{G, bx};
                    pg8::EpiScale E{Z, INW, RSSc, OFF_GATE / 256, VT, OFF_AV / 256, N == 4096 ? 12 : 13};
                    pg8::gemm_phase(tid_o, bx_o, G_o, lds3, gm, S, E);
                } else if (ls == 1) {
                    const float* pin = (g == 0 ? KIN(2) + (size_t)layer * 16384 * PLE : KIN(3) + (size_t)layer * 32768 * PLE + (size_t)(g - 1) * T * PLE);
                    prep_p(tid_o, bx_o, G_o, pin, XBc);
                    prep_qk(tid_o, bx_o, G_o, Z, (const f32x2*)(ws + WS_CS), KIN(11) + layer * 64, KIN(12) + layer * 64, N);
                    prep_pool(tid_o, bx_o, G_o, Z, YC, N);
                    hg_pass1(tid_o, bx_o, G_o, Z, ST, DEC, LBl, N, lds);
                } else if (ls == 2) {
                    hg_scan(tid_o, bx_o, G_o, ST, DEC, N);
                } else if (ls == 3) {
                    hg_pass3(tid_o, bx_o, G_o, Z, ST, YC, LBl, KIN(10) + layer * 128, N, lds);
                    attn_phase(tid_o, bx_o, G_o, Z, VT, YC, KIN(11) + layer * 64, KIN(12) + layer * 64, N, lds);
                } else if (ls == 4) {
                    pg8::Gemm gm{YC, (const bf16_t*)(ws + WS_WCAT) + (size_t)layer * DM * YLD, YLD, YLD};
                    pg8::Sched<DM, 3, 0, 8, 512, 8, 1024, 16> S{G, bx};
                    pg8::EpiMerge E{Z, FACC, MG};
                    pg8::gemm_phase(tid_o, bx_o, G_o, lds3, gm, S, E);
                } else if (ls == 5) {
                    pg8::Gemm gm{MG, (const bf16_t*)(ws + WS_WOUT) + (size_t)layer * DM * DM, DM, DM};
                    pg8::Sched<DM, 1, 0, 16, 0, 0, 0, 0> S{G, bx};
                    pg8::EpiX<0> E{XBc, xout, XBc, RSSn, nullptr, nullptr, 0};
                    pg8::gemm_phase(tid_o, bx_o, G_o, lds3, gm, S, E);
                } else if (ls == 6) {
                    pg8::Gemm gm{XBc, (const bf16_t*)(ws + WS_WUP) + (size_t)layer * DFF2 * DM, XBLD, DM};
                    pg8::Sched<DFF2, 1, 0, 16, 0, 0, 0, 0> S{G, bx};
                    pg8::EpiUp E{ws, layer, cur ^ 1};
                    pg8::gemm_phase(tid_o, bx_o, G_o, lds3, gm, S, E);
                } else if (ls == 7) {
                    conv_fix(tid_o, bx_o, G_o, EB, ACT, KIN(19) + (size_t)layer * 3 * DFF2, KIN(20) + (size_t)layer * DFF2, N);
                } else if (ls == 8) {
                    pg8::Gemm gm{ACT, (const bf16_t*)(ws + WS_WDOWN) + (size_t)layer * DM * DFF, DFF, DFF};
                    pg8::Sched<DM, 1, 0, 44, 0, 0, 0, 0> S{G, bx};
                    pg8::EpiX<0> E{XBc, xout, XBc, RSSc, nullptr, nullptr, 0};
                    pg8::gemm_phase(tid_o, bx_o, G_o, lds3, gm, S, E);
                } else {
                    pg8::Gemm gm{XBc, (const bf16_t*)(ws + WS_WPG) + (size_t)layer * DM * WPGLD, XBLD, WPGLD};
                    pg8::Sched<DM, 2, 1024, 4, 0, 16, 0, 0> S{G, bx};
                    pg8::EpiX<1> E{XBc, xout, XBn, RSSn, RSSc, FACC, layer == 3 ? 1 : 0};
                    pg8::gemm_phase(tid_o, bx_o, G_o, lds3, gm, S, E);
                }
            }
        }
        if (step + 1 < step_hi) { if (first_sync) { cg::this_grid().sync(); first_sync = false; } else xcd_barrier(gbar); }
    }
}


extern "C" void kernel_launch(void* const* d_in, const int* in_sizes, int n_in, void* d_out, int out_size, void* d_ws, size_t ws_size, hipStream_t stream) {
    static int grid = 0;
    if (grid == 0) {
        if (n_in != 26 || ws_size < WS_END) { fprintf(stderr, "kernel_launch: unexpected n_in %d or ws_size %zu (< %zu)\n", n_in, ws_size, (size_t)WS_END); grid = -1; return; }
        int dev = 0, cus = 0, per_cu = 0;
        hipGetDevice(&dev); hipDeviceGetAttribute(&cus, hipDeviceAttributeMultiprocessorCount, dev);
        hipFuncSetAttribute((const void*)mega, hipFuncAttributeMaxDynamicSharedMemorySize, LDS_BYTES);
        hipOccupancyMaxActiveBlocksPerMultiprocessor(&per_cu, (const void*)mega, 512, LDS_BYTES);
        (void)hipGetLastError();
        if (per_cu < 1) per_cu = 1;
        grid = cus * 1;
        fprintf(stderr, "kernel_launch: cus %d per_cu %d grid %d ws %zu\n", cus, per_cu, grid, ws_size);
    }
    if (grid < 0) return;
    Params p{};
    for (int i = 0; i < 26; ++i) p.in[i] = (const float*)d_in[i];
    p.out = (float*)d_out; p.ws = (unsigned char*)d_ws;
#if ONE_LAUNCH
    p.lo = 0; p.hi = NSTEPS;
    if (hipMemsetAsync((unsigned char*)d_ws + WS_BAR, 0, XCD_BAR_WORDS * 4, stream) != hipSuccess) fprintf(stderr, "memset failed\n");
    void* args[] = {&p};
    hipError_t e = hipLaunchCooperativeKernel((const void*)mega, dim3(grid), dim3(512), args, LDS_BYTES, stream);
    if (e != hipSuccess) fprintf(stderr, "cooperative launch failed: %s\n", hipGetErrorString(e));
#else
    for (int s = 0; s < NSTEPS; ++s) { p.lo = s; p.hi = s + 1; hipLaunchKernelGGL(mega, dim3(grid), dim3(512), LDS_BYTES, stream, p); }
#endif
}
```
